# Optimizing an MI355X kernel written in HIP

```python
import jax, jax.numpy as jnp
from jax import lax
import numpy as np

D_MODEL = 1024
BATCH = 2
SEQ = 8192
DEPTH = 2

ML_HEADS = 4
ML_HEAD_DIM = 256
ML_W = ML_HEADS * ML_HEAD_DIM
ML_CHUNK = 64
SC_W = D_MODEL
CONV_K = 3
SB_HEADS = 16
SB_HEAD_DIM = 64
SB_W = SB_HEADS * SB_HEAD_DIM
SB_BLOCK = 128
N_BRANCH = 3
D_FF = 4 * D_MODEL
EPS = 1e-6
SPLIT_SIZES = (ML_W, ML_W, ML_W, ML_W, ML_HEADS, ML_HEADS,
               SC_W, SC_W, SC_W,
               SB_W, SB_W, SB_W,
               D_MODEL, D_MODEL, D_MODEL)
N_IN = sum(SPLIT_SIZES)

kernel_name = "hybrid_mlstm_shortconv_stickbreaking_block"


def rmsnorm(x, g):
    xf = x.astype(jnp.float32)
    y = xf * lax.rsqrt(jnp.mean(xf * xf, axis=-1, keepdims=True) + EPS)
    return (y * g.astype(jnp.float32)).astype(x.dtype)


def _to_chunks(a, nc, L):
    a = a.reshape((a.shape[0], nc, L) + a.shape[2:])
    return jnp.swapaxes(jnp.moveaxis(a, 1, 0), 2, 3)


def mlstm(q, k, v, i_pre, f_pre):
    B_, S_, H, dh = q.shape
    L = ML_CHUNK
    nc = S_ // L
    f32 = jnp.float32
    qc = _to_chunks(q.astype(f32), nc, L)
    kc = _to_chunks(k.astype(f32) * (dh ** -0.5), nc, L)
    vc = _to_chunks(v.astype(f32), nc, L)
    ic = _to_chunks(i_pre.astype(f32), nc, L)
    lfc = _to_chunks(jax.nn.log_sigmoid(f_pre.astype(f32)), nc, L)
    causal = jnp.tril(jnp.ones((L, L), dtype=bool))

    def step(carry, xs):
        C, n, m = carry
        qb, kb, vb, ib, lfb = xs
        b = jnp.cumsum(lfb, axis=-1)
        dmat = b[..., :, None] - b[..., None, :] + ib[..., None, :]
        dmat = jnp.where(causal, dmat, -jnp.inf)
        inter = b + m[..., None]
        m_t = jnp.maximum(inter, jnp.max(dmat, axis=-1))
        w_intra = jnp.exp(dmat - m_t[..., None])
        a_inter = jnp.exp(inter - m_t)
        s = jnp.einsum('bhtd,bhsd->bhts', qb, kb) * w_intra
        num = (jnp.einsum('bhts,bhsd->bhtd', s, vb)
               + a_inter[..., None] * jnp.einsum('bhvk,bhtk->bhtv', C, qb))
        den = jnp.sum(s, axis=-1) + a_inter * jnp.einsum('bhk,bhtk->bht', n, qb)
        h = num / jnp.maximum(jnp.abs(den), jnp.exp(-m_t))[..., None]
        b_last = b[..., -1]
        g = b_last[..., None] - b + ib
        m_new = jnp.maximum(b_last + m, jnp.max(g, axis=-1))
        decay = jnp.exp(b_last + m - m_new)
        w_state = jnp.exp(g - m_new[..., None])
        C_new = decay[..., None, None] * C + jnp.einsum('bhs,bhsv,bhsk->bhvk', w_state, vb, kb)
        n_new = decay[..., None] * n + jnp.einsum('bhs,bhsk->bhk', w_state, kb)
        return (C_new, n_new, m_new), h

    init = (jnp.zeros((B_, H, dh, dh), f32), jnp.zeros((B_, H, dh), f32), jnp.zeros((B_, H), f32))
    _, hs = lax.scan(step, init, (qc, kc, vc, ic, lfc))
    hs = jnp.moveaxis(jnp.swapaxes(hs, 2, 3), 0, 1)
    return hs.reshape(B_, S_, H, dh)


def short_conv(gate_b, gate_c, u, w):
    z = gate_c * u
    y = lax.conv_general_dilated(
        z, w[:, None, :].astype(z.dtype), window_strides=(1,),
        padding=[(CONV_K - 1, 0)], dimension_numbers=('NWC', 'WIO', 'NWC'),
        feature_group_count=z.shape[-1])
    return gate_b * y


def stick_breaking(q, k, v):
    B_, S_, H, d = q.shape
    nb = S_ // SB_BLOCK
    f32 = jnp.float32
    qf = q.astype(f32) * (d ** -0.5)
    kf = k.astype(f32)
    vf = v.astype(f32)
    q_blocks = jnp.transpose(qf.reshape(B_, nb, SB_BLOCK, H, d), (1, 0, 3, 2, 4))
    starts = jnp.arange(nb, dtype=jnp.int32) * SB_BLOCK
    key_pos = jnp.arange(S_, dtype=jnp.int32)

    def block(args):
        qblk, start = args
        q_pos = start + jnp.arange(SB_BLOCK, dtype=jnp.int32)
        mask = key_pos[None, :] < q_pos[:, None]
        z = jnp.einsum('bhqd,bshd->bhqs', qblk, kf)
        log_beta = jax.nn.log_sigmoid(z)
        log_1m = jnp.where(mask, log_beta - z, 0.0)
        cum = jnp.cumsum(log_1m, axis=-1)
        log_a = log_beta + cum[..., -1:] - cum
        a = jnp.where(mask, jnp.exp(log_a), 0.0)
        return jnp.einsum('bhqs,bshd->bqhd', a, vf)

    out = lax.map(block, (q_blocks, starts))
    return jnp.moveaxis(out, 0, 1).reshape(B_, S_, H * d)


def head_rmsnorm(h, g, n_heads):
    B_, S_, W = h.shape
    hh = h.reshape(B_, S_, n_heads, W // n_heads)
    hh = hh * lax.rsqrt(jnp.mean(hh * hh, axis=-1, keepdims=True) + EPS)
    return hh.reshape(B_, S_, W) * g.astype(jnp.float32)


def setup_inputs(seed: int = 0) -> dict:
    key = jax.random.key(seed)
    ks = jax.random.split(key, 16)
    nrm = jax.random.normal
    x = nrm(ks[0], (BATCH, SEQ, D_MODEL), jnp.float32)
    norm_mix_g = 1.0 + 0.02 * nrm(ks[1], (DEPTH, D_MODEL), jnp.float32)
    w_in = nrm(ks[2], (DEPTH, D_MODEL, N_IN), jnp.float32) * D_MODEL ** -0.5
    b_if = jnp.concatenate([
        0.1 * nrm(ks[3], (DEPTH, ML_HEADS), jnp.float32),
        jnp.linspace(3.0, 6.0, ML_HEADS, dtype=jnp.float32)[None, :]
        + 0.1 * nrm(ks[4], (DEPTH, ML_HEADS), jnp.float32)], axis=-1)
    ml_norm_g = 1.0 + 0.02 * nrm(ks[5], (DEPTH, ML_W), jnp.float32)
    conv_w = nrm(ks[6], (DEPTH, CONV_K, SC_W), jnp.float32) * CONV_K ** -0.5
    w_ml_proj = nrm(ks[7], (DEPTH, ML_W, D_MODEL), jnp.float32) * ML_W ** -0.5
    w_sc_proj = nrm(ks[8], (DEPTH, SC_W, D_MODEL), jnp.float32) * SC_W ** -0.5
    w_sb_proj = nrm(ks[9], (DEPTH, SB_W, D_MODEL), jnp.float32) * SB_W ** -0.5
    w_out = nrm(ks[10], (DEPTH, D_MODEL, D_MODEL), jnp.float32) * D_MODEL ** -0.5
    norm_mlp_g = 1.0 + 0.02 * nrm(ks[11], (DEPTH, D_MODEL), jnp.float32)
    w_up = nrm(ks[12], (DEPTH, D_MODEL, D_FF), jnp.float32) * D_MODEL ** -0.5
    w_down = nrm(ks[13], (DEPTH, D_FF, D_MODEL), jnp.float32) * D_FF ** -0.5
    norm_final_g = 1.0 + 0.02 * nrm(ks[14], (D_MODEL,), jnp.float32)
    return {"x": x, "norm_mix_g": norm_mix_g, "w_in": w_in, "b_if": b_if,
            "ml_norm_g": ml_norm_g, "conv_w": conv_w, "w_ml_proj": w_ml_proj,
            "w_sc_proj": w_sc_proj, "w_sb_proj": w_sb_proj, "w_out": w_out,
            "norm_mlp_g": norm_mlp_g, "w_up": w_up, "w_down": w_down,
            "norm_final_g": norm_final_g}


def reference(x, norm_mix_g, w_in, b_if, ml_norm_g, conv_w, w_ml_proj, w_sc_proj,
              w_sb_proj, w_out, norm_mlp_g, w_up, w_down, norm_final_g):
    B_, S_, _ = x.shape
    offsets = []
    acc = 0
    for sz in SPLIT_SIZES[:-1]:
        acc += sz
        offsets.append(acc)
    for l in range(DEPTH):
        h = rmsnorm(x, norm_mix_g[l])
        proj = h @ w_in[l]
        (ml_q, ml_k, ml_v, ml_o, ml_i, ml_f,
         sc_b, sc_c, sc_u,
         sb_q, sb_k, sb_v,
         g_ml, g_sc, g_sb) = jnp.split(proj, offsets, axis=-1)
        i_pre = ml_i + b_if[l, :ML_HEADS]
        f_pre = ml_f + b_if[l, ML_HEADS:]
        h_tilde = mlstm(ml_q.reshape(B_, S_, ML_HEADS, ML_HEAD_DIM),
                        ml_k.reshape(B_, S_, ML_HEADS, ML_HEAD_DIM),
                        ml_v.reshape(B_, S_, ML_HEADS, ML_HEAD_DIM),
                        i_pre, f_pre).reshape(B_, S_, ML_W)
        y_ml = head_rmsnorm(jax.nn.sigmoid(ml_o.astype(jnp.float32)) * h_tilde,
                            ml_norm_g[l], ML_HEADS).astype(x.dtype)
        y_sc = short_conv(sc_b, sc_c, sc_u, conv_w[l])
        y_sb = stick_breaking(sb_q.reshape(B_, S_, SB_HEADS, SB_HEAD_DIM),
                              sb_k.reshape(B_, S_, SB_HEADS, SB_HEAD_DIM),
                              sb_v.reshape(B_, S_, SB_HEADS, SB_HEAD_DIM)).astype(x.dtype)
        merged = (jax.nn.sigmoid(g_ml) * (y_ml @ w_ml_proj[l])
                  + jax.nn.sigmoid(g_sc) * (y_sc @ w_sc_proj[l])
                  + jax.nn.sigmoid(g_sb) * (y_sb @ w_sb_proj[l]))
        x = x + merged @ w_out[l]
        h2 = rmsnorm(x, norm_mlp_g[l])
        x = x + jnp.square(jax.nn.relu(h2 @ w_up[l])) @ w_down[l]
    return rmsnorm(x, norm_final_g)
```

```cpp
#include <hip/hip_runtime.h>
#include <hip/hip_cooperative_groups.h>
#include <cstdio>
#include <cstdint>
namespace cg = cooperative_groups;
namespace pg8 {
#define PG8_LAS __attribute__((address_space(3)))
typedef unsigned short bf16_t;
typedef short bf16x8 __attribute__((ext_vector_type(8)));
typedef float f32x4 __attribute__((ext_vector_type(4)));
typedef unsigned u32x4 __attribute__((ext_vector_type(4)));
constexpr int BM = 256, BK = 64, HALF = 128, HTB = HALF * BK * 2  , STAGE_BYTES = 8 * HTB, NXCD = 8, WGM = 8;

__host__ __device__ __forceinline__ int lds_byte(int r, int c) { const int st = (r >> 4) * 2 + (c >> 5), rr = r & 15, cc = c & 31, ob = rr * 64 + cc * 2; return st * 1024 + (ob ^ (((ob >> 9) & 1) << 5)); }
__host__ __device__ __forceinline__ void stage_rc(int b, int& R, int& C) { const int st = b / 1024, sb = b % 1024, swz = sb ^ (((sb >> 9) & 1) << 5); R = (st >> 1) * 16 + swz / 64; C = (st & 1) * 32 + (swz % 64) / 2; }
__host__ __device__ __forceinline__ int perm32(int rho) { const int n = rho >> 4, i = rho & 15; return 8 * (i >> 2) + 4 * n + (i & 3); }

struct Unit { int pm, pn; };
struct Gemm { const bf16_t* A; const bf16_t* Bt; int M, N, K; };

struct StaticOrder {
    int nM, nN, nwg, G, c;
    __host__ __device__ void init(int M, int N, int G_, int c_) { nM = M / BM; nN = N / BM; nwg = nM * nN; G = G_; c = c_; }
    __host__ __device__ bool next(int i, Unit& u) const {
        const long L = (long)i * G + c; if (L >= nwg) return false;
        int wgid = (int)L; { const int q = nwg / NXCD, r = nwg % NXCD, xcd = wgid % NXCD, off = wgid / NXCD; wgid = (xcd < r ? xcd * (q + 1) : r * (q + 1) + (xcd - r) * q) + off; }
        const int nig = WGM * nN, gid = wgid / nig, fm = gid * WGM, gsz = (nM - fm) < WGM ? (nM - fm) : WGM;
        u.pm = fm + ((wgid % nig) % gsz); u.pn = (wgid % nig) / gsz; return true;
    }
    __device__ __forceinline__ void a_ready(const Unit&) const {}
    __device__ __forceinline__ void done(const Unit&) const {}
};

__device__ __forceinline__ unsigned cvt_pk_bf16(float lo, float hi) { unsigned r; asm volatile("v_cvt_pk_bf16_f32 %0, %1, %2" : "=v"(r) : "v"(lo), "v"(hi)); return r; }
typedef float f32x2 __attribute__((ext_vector_type(2)));
__device__ __forceinline__ f32x2 gelu_pk(f32x2 v) {
    const f32x2 av = __builtin_elementwise_abs(v), d = av * 0.2316418882f + 1.0f;
    f32x2 t; t.x = __builtin_amdgcn_rcpf(d.x); t.y = __builtin_amdgcn_rcpf(d.y);
    f32x2 q = t * 0.5307027145f + (-0.7265760135f); q = q * t + 0.7107068705f; q = q * t + (-0.142248368f); q = q * t + 0.127414796f; q = q * t;
    const f32x2 s = (v * v) * (-0.72134752044f);
    f32x2 e; e.x = __builtin_amdgcn_exp2f(s.x); e.y = __builtin_amdgcn_exp2f(s.y);
    const f32x2 m = v * (q * e), r = v - m;
    f32x2 o; o.x = v.x < 0.f ? m.x : r.x; o.y = v.y < 0.f ? m.y : r.y; return o;
}

template <int ACT  > struct EpiBf16 {
    static constexpr bool PERM = true, AFTER_DRAIN = false; static_assert(ACT == 0 || ACT == 1, "EpiBf16: ACT is 0 (none) or 1 (gelu_pk)");
    bf16_t* O; int ldc; const float* bias; int split_cols; size_t split_stride; float scale0;
    __device__ __forceinline__ void operator()(const f32x4 (&acc)[2][2][4][2], const Unit& u, int wr, int wc, int fr, int fq) const {
        const int row0 = u.pm * BM + wr * 64 + fr; int colt = u.pn * BM; bf16_t* base = O;
        float sc = 1.f; if (split_cols) { const int t = colt / split_cols; base += (size_t)t * split_stride; colt -= t * split_cols; if (t == 0) sc = scale0; }
        const int col0 = colt + wc * 32 + 8 * fq, bcol0 = u.pn * BM + wc * 32 + 8 * fq;
        f32x4 bv[2][2];
#pragma unroll
        for (int bj = 0; bj < 2; ++bj)
#pragma unroll
            for (int n = 0; n < 2; ++n) bv[bj][n] = bias ? *(const f32x4*)(bias + bcol0 + bj * HALF + 4 * n) : (f32x4){0.f, 0.f, 0.f, 0.f};
#pragma unroll
        for (int ai = 0; ai < 2; ++ai)
#pragma unroll
            for (int m = 0; m < 4; ++m) { bf16_t* rowp = base + (size_t)(row0 + ai * HALF + m * 16) * ldc + col0;
#pragma unroll
                for (int bj = 0; bj < 2; ++bj) { f32x4 v0 = acc[ai][bj][m][0] + bv[bj][0], v1 = acc[ai][bj][m][1] + bv[bj][1];
                    if (ACT == 1) { f32x2 a = gelu_pk((f32x2){v0[0], v0[1]}), b = gelu_pk((f32x2){v0[2], v0[3]}), c = gelu_pk((f32x2){v1[0], v1[1]}), d = gelu_pk((f32x2){v1[2], v1[3]});
                        v0 = (f32x4){a.x, a.y, b.x, b.y}; v1 = (f32x4){c.x, c.y, d.x, d.y}; }
                    v0 = v0 * sc; v1 = v1 * sc; u32x4 w; w.x = cvt_pk_bf16(v0[0], v0[1]); w.y = cvt_pk_bf16(v0[2], v0[3]); w.z = cvt_pk_bf16(v1[0], v1[1]); w.w = cvt_pk_bf16(v1[2], v1[3]);
                    *(u32x4*)(rowp + bj * HALF) = w; } }
    }
};

struct PanelStats {
    unsigned* xbuf;
    unsigned* cnt;
    unsigned* tmo;
    int ntn; float eps;
    unsigned code;
    __device__ __forceinline__ bool run(const f32x4 (&v)[2][2][4][2], const Unit& u, int wr, int wc, int fr, int fq, PG8_LAS unsigned char* lds, int wid, int lane) const {
        typedef float f32x2v __attribute__((ext_vector_type(2)));
        PG8_LAS f32x2v* P = (PG8_LAS f32x2v*)lds;
        PG8_LAS f32x2v* S = (PG8_LAS f32x2v*)(lds + 8192);
        PG8_LAS unsigned* flag = (PG8_LAS unsigned*)(lds + 8192 + 2048);
#pragma unroll
        for (int ai = 0; ai < 2; ++ai)
#pragma unroll
            for (int m = 0; m < 4; ++m) {
                float s = 0.f;
#pragma unroll
                for (int bj = 0; bj < 2; ++bj)
#pragma unroll
                    for (int n = 0; n < 2; ++n) { const f32x4 x = v[ai][bj][m][n]; s += (x[0] + x[1]) + (x[2] + x[3]); }
                s += __shfl_xor(s, 16); s += __shfl_xor(s, 32);
                const float mw = s * (1.0f / 64.0f); float q = 0.f;
#pragma unroll
                for (int bj = 0; bj < 2; ++bj)
#pragma unroll
                    for (int n = 0; n < 2; ++n) { const f32x4 d = v[ai][bj][m][n] - mw; q += (d[0] * d[0] + d[1] * d[1]) + (d[2] * d[2] + d[3] * d[3]); }
                q += __shfl_xor(q, 16); q += __shfl_xor(q, 32);
                if (fq == 0) P[(ai * HALF + wr * 64 + m * 16 + fr) * 4 + wc] = (f32x2v){mw, q};
            }
        asm volatile("s_waitcnt lgkmcnt(0)" ::: "memory"); __builtin_amdgcn_s_barrier(); asm volatile("" ::: "memory");
#if defined(BROKEN_EXCHANGE_NO_WAIT)
#warning BROKEN CONTROL BUILD: the row-statistics exchange does not wait; results are wrong by design
        if (blockIdx.x >= 64) { const long long t0_ = clock64(); while (clock64() - t0_ < 60000) __builtin_amdgcn_s_sleep(8); }
#endif
        const int row = wid * 32 + (lane & 31);
        if (lane < 32) {
            const f32x2v a = P[row * 4 + 0], b = P[row * 4 + 1], c = P[row * 4 + 2], d = P[row * 4 + 3];
            const float mt = (a.x + b.x + c.x + d.x) * 0.25f;
            const float da = a.x - mt, db = b.x - mt, dc = c.x - mt, dd = d.x - mt;
            const float m2 = (a.y + b.y) + (c.y + d.y) + 64.0f * ((da * da + db * db) + (dc * dc + dd * dd));
            unsigned long long* slot = (unsigned long long*)xbuf + ((size_t)(u.pm * BM + row) * 4 + u.pn);
            __hip_atomic_store(slot, ((unsigned long long)__float_as_uint(m2) << 32) | __float_as_uint(mt), __ATOMIC_RELAXED, __HIP_MEMORY_SCOPE_AGENT);
        }
        asm volatile("s_waitcnt vmcnt(0)" ::: "memory");
        if (lane == 0) __hip_atomic_fetch_add(cnt + 64 * u.pm, 1u, __ATOMIC_RELAXED, __HIP_MEMORY_SCOPE_AGENT);
        if (wid == 0) {
            bool dead = false; const unsigned long long t0 = __builtin_amdgcn_s_memrealtime(); const unsigned want = 8u * (unsigned)ntn;
            for (;;) {
#if defined(BROKEN_EXCHANGE_NO_WAIT)
                break;
#endif
                if ((unsigned)__builtin_amdgcn_readfirstlane(__hip_atomic_load(cnt + 64 * u.pm, __ATOMIC_RELAXED, __HIP_MEMORY_SCOPE_AGENT)) >= want) break;
                if (__builtin_amdgcn_s_memrealtime() - t0 > 2000000ull) {
                    if (lane == 0) { unsigned expect = 0u; __hip_atomic_compare_exchange_strong(tmo + 1, &expect, code | (unsigned)(u.pm & 0xff), __ATOMIC_RELAXED, __ATOMIC_RELAXED, __HIP_MEMORY_SCOPE_AGENT);
                                     __hip_atomic_store(tmo, 1u, __ATOMIC_RELAXED, __HIP_MEMORY_SCOPE_AGENT); }
                    dead = true; break; }
                __builtin_amdgcn_s_sleep(2);
            }
            __builtin_amdgcn_fence(__ATOMIC_ACQUIRE, "agent");
            if (lane == 0) flag[0] = dead ? 1u : 0u;
        }
        asm volatile("s_waitcnt vmcnt(0) lgkmcnt(0)" ::: "memory"); __builtin_amdgcn_s_barrier(); asm volatile("" ::: "memory");
        const bool bad = flag[0] != 0u;
        if (lane < 32) {
            const unsigned long long* slot = (const unsigned long long*)xbuf + (size_t)(u.pm * BM + row) * 4; float mt[4], m2[4]; float ms = 0.f;
#pragma unroll
            for (int t = 0; t < 4; ++t) { if (t < ntn) { const unsigned long long w = __hip_atomic_load(slot + t, __ATOMIC_RELAXED, __HIP_MEMORY_SCOPE_AGENT); mt[t] = __uint_as_float((unsigned)w); m2[t] = __uint_as_float((unsigned)(w >> 32)); } else { mt[t] = 0.f; m2[t] = 0.f; } ms += mt[t]; }
            const float mean = ms / (float)ntn; float q = 0.f;
#pragma unroll
            for (int t = 0; t < 4; ++t) if (t < ntn) { const float dm = mt[t] - mean; q += m2[t] + 256.0f * dm * dm; }
            S[row] = (f32x2v){mean, 1.0f / sqrtf(q / (256.0f * (float)ntn) + eps)};
        }
        asm volatile("s_waitcnt lgkmcnt(0)" ::: "memory"); __builtin_amdgcn_s_barrier(); asm volatile("" ::: "memory");
        return bad;
    }
};
struct EpiLnRes {
    static constexpr bool PERM = false, AFTER_DRAIN = true;
    const float* base; float* out; int ldc; const float* bias; PanelStats st; unsigned poison;
    __device__ __forceinline__ void fused(f32x4 (&acc)[2][2][4][2], const Unit& u, int wr, int wc, int fr, int fq, PG8_LAS unsigned char* lds, int wid, int lane) const {
        typedef float f32x2v __attribute__((ext_vector_type(2)));
        const PG8_LAS f32x2v* S = (const PG8_LAS f32x2v*)(lds + 8192);
        const int col0 = u.pn * BM + wc * 32 + 4 * fq;
#pragma unroll
        for (int bj = 0; bj < 2; ++bj)
#pragma unroll
            for (int n = 0; n < 2; ++n) { const f32x4 bv = bias ? *(const f32x4*)(bias + col0 + bj * HALF + n * 16) : (f32x4){0.f, 0.f, 0.f, 0.f};
#pragma unroll
                for (int ai = 0; ai < 2; ++ai)
#pragma unroll
                    for (int m = 0; m < 4; ++m) acc[ai][bj][m][n] += bv; }
        f32x4 pre[4][2][2];
#pragma unroll
        for (int m = 0; m < 4; ++m) { const size_t off = (size_t)(u.pm * BM + wr * 64 + m * 16 + fr) * ldc + col0;
#pragma unroll
            for (int bj = 0; bj < 2; ++bj)
#pragma unroll
                for (int n = 0; n < 2; ++n) pre[m][bj][n] = *(const f32x4*)(base + off + bj * HALF + n * 16); }
        const bool bad = st.run(acc, u, wr, wc, fr, fq, lds, wid, lane) || poison != 0u;
        const float qnan = __builtin_nanf("");
#pragma unroll
        for (int ai = 0; ai < 2; ++ai)
#pragma unroll
            for (int m = 0; m < 4; ++m) { const int r = ai * HALF + wr * 64 + m * 16 + fr; const f32x2v sr = S[r]; const size_t off = (size_t)(u.pm * BM + r) * ldc + col0;
#pragma unroll
                for (int bj = 0; bj < 2; ++bj)
#pragma unroll
                    for (int n = 0; n < 2; ++n) { const f32x4 bs = ai == 0 ? pre[m][bj][n] : *(const f32x4*)(base + off + bj * HALF + n * 16); f32x4 o = bs + (acc[ai][bj][m][n] - sr.x) * sr.y;
                        if (bad) o = (f32x4){qnan, qnan, qnan, qnan}; *(f32x4*)(out + off + bj * HALF + n * 16) = o; }
                if (m & 1) asm volatile("" ::: "memory"); }
    }
};
struct EpiLnResLn {
    static constexpr bool PERM = false, AFTER_DRAIN = true;
    const float* base; float* out; bf16_t* xn; int ldc; const float* bias; PanelStats st1, st2; unsigned poison;
    __device__ __forceinline__ void fused(f32x4 (&acc)[2][2][4][2], const Unit& u, int wr, int wc, int fr, int fq, PG8_LAS unsigned char* lds, int wid, int lane) const {
        typedef float f32x2v __attribute__((ext_vector_type(2))); typedef unsigned u32x2v __attribute__((ext_vector_type(2)));
        const PG8_LAS f32x2v* S = (const PG8_LAS f32x2v*)(lds + 8192);
        const int col0 = u.pn * BM + wc * 32 + 4 * fq;
#pragma unroll
        for (int bj = 0; bj < 2; ++bj)
#pragma unroll
            for (int n = 0; n < 2; ++n) { const f32x4 bv = bias ? *(const f32x4*)(bias + col0 + bj * HALF + n * 16) : (f32x4){0.f, 0.f, 0.f, 0.f};
#pragma unroll
                for (int ai = 0; ai < 2; ++ai)
#pragma unroll
                    for (int m = 0; m < 4; ++m) acc[ai][bj][m][n] += bv; }
        bool bad = st1.run(acc, u, wr, wc, fr, fq, lds, wid, lane) || poison != 0u;
        const float qnan = __builtin_nanf("");
#pragma unroll
        for (int ai = 0; ai < 2; ++ai)
#pragma unroll
            for (int m = 0; m < 4; ++m) { const int r = ai * HALF + wr * 64 + m * 16 + fr; const f32x2v sr = S[r]; const size_t off = (size_t)(u.pm * BM + r) * ldc + col0;
#pragma unroll
                for (int bj = 0; bj < 2; ++bj)
#pragma unroll
                    for (int n = 0; n < 2; ++n) { const f32x4 bs = *(const f32x4*)(base + off + bj * HALF + n * 16); acc[ai][bj][m][n] = bs + (acc[ai][bj][m][n] - sr.x) * sr.y; }
                asm volatile("" : "+v"(acc[ai][0][m][0]), "+v"(acc[ai][0][m][1]), "+v"(acc[ai][1][m][0]), "+v"(acc[ai][1][m][1]));
                if (m & 1) asm volatile("" ::: "memory"); }
        const bool bad1 = bad;
        bad = st2.run(acc, u, wr, wc, fr, fq, lds, wid, lane) || bad;
#pragma unroll
        for (int ai = 0; ai < 2; ++ai)
#pragma unroll
            for (int m = 0; m < 4; ++m) { const int r = ai * HALF + wr * 64 + m * 16 + fr; const f32x2v sr = S[r]; const size_t off = (size_t)(u.pm * BM + r) * ldc + col0;
#pragma unroll
                for (int bj = 0; bj < 2; ++bj)
#pragma unroll
                    for (int n = 0; n < 2; ++n) { const f32x4 x1 = acc[ai][bj][m][n]; *(f32x4*)(out + off + bj * HALF + n * 16) = bad1 ? (f32x4){qnan, qnan, qnan, qnan} : x1;
                        const f32x4 o = (x1 - sr.x) * sr.y; u32x2v w; w.x = cvt_pk_bf16(o[0], o[1]); w.y = cvt_pk_bf16(o[2], o[3]);
                        if (bad) { w.x = 0x7fc07fc0u; w.y = 0x7fc07fc0u; } *(u32x2v*)(xn + off + bj * HALF + n * 16) = w; }
                asm volatile("" ::: "memory"); }
    }
};

template <class Epi, class Sched, bool ALIGN_EPI = false, bool SP2 = false>
__device__ __forceinline__ void gemm_phase(PG8_LAS unsigned char* lds, const Gemm g, const Sched& S, const Epi& E) {
    const int tid = threadIdx.x, wid = __builtin_amdgcn_readfirstlane(tid >> 6), lane = tid & 63, wr = wid >> 2, wc = wid & 3, fr = lane & 15, fq = lane >> 4;
    const int K = g.K, nt = K / BK;
    unsigned voffA[2], voffB[2];
#pragma unroll
    for (int i = 0; i < 2; ++i) { int R, C; stage_rc(tid * 16 + i * 8192, R, C); const int Rb = Epi::PERM ? ((R & ~31) + perm32(R & 31)) : R;
        voffA[i] = (unsigned)(R * K + C) * 2u; voffB[i] = (unsigned)(Rb * K + C) * 2u; }
    const size_t kstep = (size_t)(BK * 2);
    const size_t hstep = (size_t)HALF * K * 2;
    const size_t tstep = 2 * hstep;
    const unsigned ldsw = (unsigned)wid * 1024u;
    const int aoff = lds_byte(wr * 64 + fr, fq * 8), boff = lds_byte(wc * 32 + fr, fq * 8);
#define PG8_SA(b, h) (((b) * 2 + (h)) * HTB)
#define PG8_SB(b, h) ((4 + (b) * 2 + (h)) * HTB)
#define PG8_STAGE(bufoff, gbase, voff) do { _Pragma("unroll") for (int _i = 0; _i < 2; ++_i) \
        __builtin_amdgcn_global_load_lds((const unsigned*)((const char*)(gbase) + (voff)[_i]), (PG8_LAS unsigned*)(lds + (bufoff) + ldsw + _i * 8192), 16, 0, 0); } while (0)
#define PG8_LDA(dst, b, h) do { _Pragma("unroll") for (int m = 0; m < 4; ++m) _Pragma("unroll") for (int k = 0; k < 2; ++k) dst[m][k] = *(const PG8_LAS bf16x8*)(lds + PG8_SA(b, h) + aoff + m * 2048 + k * 1024); } while (0)
#define PG8_LDB(dst, b, h) do { _Pragma("unroll") for (int n = 0; n < 2; ++n) _Pragma("unroll") for (int k = 0; k < 2; ++k) dst[n][k] = *(const PG8_LAS bf16x8*)(lds + PG8_SB(b, h) + boff + n * 2048 + k * 1024); } while (0)
#define PG8_MMA(ai, bj, At, Bt) do { __builtin_amdgcn_s_setprio(1); _Pragma("unroll") for (int m = 0; m < 4; ++m) _Pragma("unroll") for (int n = 0; n < 2; ++n) _Pragma("unroll") for (int k = 0; k < 2; ++k) \
        acc[ai][bj][m][n] = __builtin_amdgcn_mfma_f32_16x16x32_bf16(Bt[n][k], At[m][k], acc[ai][bj][m][n], 0, 0, 0); __builtin_amdgcn_s_setprio(0); } while (0)
#define PG8_WAIT_V(n) asm volatile("s_waitcnt vmcnt(" #n ")" ::: "memory")
#define PG8_WAIT_L(n) asm volatile("s_waitcnt lgkmcnt(" #n ")" ::: "memory")
#define PG8_BAR __builtin_amdgcn_s_barrier()
#define PG8_SCHED __builtin_amdgcn_sched_barrier(0)
    Unit cur, nxt; int ui = 0;
    if (!S.next(0, cur)) return;
    f32x4 acc[2][2][4][2];
#pragma unroll
    for (int a = 0; a < 2; ++a)
#pragma unroll
        for (int b = 0; b < 2; ++b)
#pragma unroll
            for (int m = 0; m < 4; ++m)
#pragma unroll
                for (int n = 0; n < 2; ++n) acc[a][b][m][n] = (f32x4){0.f, 0.f, 0.f, 0.f};
    bf16x8 At[4][2], B0[2][2], B1[2][2];
    const char* cA = (const char*)g.A + (size_t)cur.pm * tstep; const char* cB = (const char*)g.Bt + (size_t)cur.pn * tstep;
    S.a_ready(cur);
    if constexpr (SP2) {
        PG8_STAGE(PG8_SB(0, 0), cB, voffB); PG8_STAGE(PG8_SB(0, 1), cB + hstep, voffB); PG8_STAGE(PG8_SA(0, 0), cA, voffA); PG8_STAGE(PG8_SA(0, 1), cA + hstep, voffA);
        if (wr == 1) PG8_BAR;
        PG8_WAIT_V(2); PG8_BAR;
        PG8_STAGE(PG8_SB(1, 0), cB + kstep, voffB); PG8_STAGE(PG8_SA(1, 0), cA + kstep, voffA); PG8_STAGE(PG8_SB(1, 1), cB + hstep + kstep, voffB);
        PG8_WAIT_V(6); PG8_BAR;
    } else {
        PG8_STAGE(PG8_SB(0, 0), cB, voffB); PG8_STAGE(PG8_SA(0, 0), cA, voffA); PG8_STAGE(PG8_SB(0, 1), cB + hstep, voffB); PG8_STAGE(PG8_SA(0, 1), cA + hstep, voffA);
        if (wr == 1) PG8_BAR;
        PG8_WAIT_V(4); PG8_BAR;
        PG8_STAGE(PG8_SB(1, 0), cB + kstep, voffB); PG8_STAGE(PG8_SA(1, 0), cA + kstep, voffA); PG8_STAGE(PG8_SB(1, 1), cB + hstep + kstep, voffB);
        PG8_WAIT_V(6); PG8_BAR;
    }
    for (;;) {
        const bool has_next = S.next(ui + 1, nxt);
        const char* nA = has_next ? (const char*)g.A + (size_t)nxt.pm * tstep : cA; const char* nB = has_next ? (const char*)g.Bt + (size_t)nxt.pn * tstep : cB;
        for (int t = 0; t < nt; t += 2) {
            const bool last = (t == nt - 2);
            const char* a1 = cA + (size_t)(t + 1) * kstep;
            const char* a2 = last ? nA : cA + (size_t)(t + 2) * kstep; const char* b2 = last ? nB : cB + (size_t)(t + 2) * kstep;
            const char* a3 = a2 + kstep; const char* b3 = b2 + kstep;
            if (last && has_next) S.a_ready(nxt);
            if constexpr (SP2) {
            PG8_LDB(B0, 0, 0); PG8_LDB(B1, 0, 1); PG8_SCHED; PG8_LDA(At, 0, 0); PG8_STAGE(PG8_SA(1, 1), a1 + hstep, voffA);
            PG8_WAIT_V(8); PG8_WAIT_L(0); PG8_BAR; PG8_MMA(0, 0, At, B0); PG8_MMA(0, 1, At, B1); PG8_BAR; PG8_SCHED;
            PG8_LDA(At, 0, 1); PG8_STAGE(PG8_SB(0, 0), b2, voffB); PG8_STAGE(PG8_SB(0, 1), b2 + hstep, voffB); PG8_STAGE(PG8_SA(0, 0), a2, voffA);
            PG8_WAIT_V(8); PG8_WAIT_L(0); PG8_BAR; PG8_MMA(1, 0, At, B0); PG8_MMA(1, 1, At, B1); PG8_BAR; PG8_SCHED;
            PG8_LDB(B0, 1, 0); PG8_LDB(B1, 1, 1); PG8_SCHED; PG8_LDA(At, 1, 0); PG8_STAGE(PG8_SA(0, 1), a2 + hstep, voffA);
            PG8_WAIT_V(8); PG8_WAIT_L(0); PG8_BAR; PG8_MMA(0, 0, At, B0); PG8_MMA(0, 1, At, B1); PG8_BAR; PG8_SCHED;
            PG8_LDA(At, 1, 1); PG8_STAGE(PG8_SB(1, 0), b3, voffB); PG8_STAGE(PG8_SB(1, 1), b3 + hstep, voffB); PG8_STAGE(PG8_SA(1, 0), a3, voffA);
            PG8_WAIT_V(8); PG8_WAIT_L(0); PG8_BAR; PG8_MMA(1, 0, At, B0); PG8_MMA(1, 1, At, B1); PG8_BAR; PG8_SCHED;
            } else {
            PG8_LDB(B0, 0, 0); PG8_SCHED; PG8_LDA(At, 0, 0); PG8_STAGE(PG8_SA(1, 1), a1 + hstep, voffA);
            PG8_WAIT_L(8); PG8_BAR; PG8_WAIT_L(0); PG8_MMA(0, 0, At, B0); PG8_BAR; PG8_SCHED;
            PG8_LDB(B1, 0, 1); PG8_STAGE(PG8_SB(0, 0), b2, voffB);
            PG8_BAR; PG8_WAIT_L(0); PG8_MMA(0, 1, At, B1); PG8_BAR;
            PG8_LDA(At, 0, 1); PG8_STAGE(PG8_SA(0, 0), a2, voffA);
            PG8_BAR; PG8_WAIT_L(0); PG8_MMA(1, 0, At, B0); PG8_BAR; PG8_SCHED;
            PG8_STAGE(PG8_SB(0, 1), b2 + hstep, voffB);
            PG8_WAIT_V(6); PG8_BAR; PG8_MMA(1, 1, At, B1); PG8_BAR;
            PG8_LDB(B0, 1, 0); PG8_SCHED; PG8_LDA(At, 1, 0); PG8_STAGE(PG8_SA(0, 1), a2 + hstep, voffA);
            PG8_WAIT_L(8); PG8_BAR; PG8_WAIT_L(0); PG8_MMA(0, 0, At, B0); PG8_BAR; PG8_SCHED;
            PG8_LDB(B1, 1, 1); PG8_STAGE(PG8_SB(1, 0), b3, voffB);
            PG8_BAR; PG8_WAIT_L(0); PG8_MMA(0, 1, At, B1); PG8_BAR;
            PG8_LDA(At, 1, 1); PG8_STAGE(PG8_SA(1, 0), a3, voffA);
            PG8_BAR; PG8_WAIT_L(0); PG8_MMA(1, 0, At, B0); PG8_BAR; PG8_SCHED;
            PG8_STAGE(PG8_SB(1, 1), b3 + hstep, voffB);
            PG8_WAIT_V(6); PG8_BAR; PG8_MMA(1, 1, At, B1); PG8_BAR;
            }
        }
        if constexpr (ALIGN_EPI) { if (wr == 0) PG8_BAR; }
        if constexpr (!Epi::AFTER_DRAIN) { E(acc, cur, wr, wc, fr, fq); S.done(cur); }
        if (!has_next) break;
#pragma unroll
        for (int a = 0; a < 2; ++a)
#pragma unroll
            for (int b = 0; b < 2; ++b)
#pragma unroll
                for (int m = 0; m < 4; ++m)
#pragma unroll
                    for (int n = 0; n < 2; ++n) acc[a][b][m][n] = (f32x4){0.f, 0.f, 0.f, 0.f};
        cur = nxt; cA = nA; cB = nB; ++ui;
        if constexpr (ALIGN_EPI) { if (wr == 1) PG8_BAR; }
    }
    PG8_WAIT_V(0);
    if constexpr (!ALIGN_EPI) { if (wr == 0) PG8_BAR; }
    PG8_BAR;
    if constexpr (Epi::AFTER_DRAIN) { E.fused(acc, cur, wr, wc, fr, fq, lds, wid, lane); S.done(cur); }
#undef PG8_SA
#undef PG8_SB
#undef PG8_STAGE
#undef PG8_LDA
#undef PG8_LDB
#undef PG8_MMA
#undef PG8_WAIT_V
#undef PG8_WAIT_L
#undef PG8_BAR
#undef PG8_SCHED
}
}
namespace pg8 {
struct EpiStore {
    static constexpr bool PERM = true, AFTER_DRAIN = false;
    bf16_t* O; int ldc; int split_cols; size_t split_stride; int act; int act_from;
    __device__ __forceinline__ void operator()(const f32x4 (&acc)[2][2][4][2], const Unit& u, int wr, int wc, int fr, int fq) const {
        const int row0 = u.pm * BM + wr * 64 + fr; int colt = u.pn * BM; bf16_t* base = O; int a = act;
        if (split_cols) { const int t = colt / split_cols; base += (size_t)t * split_stride; colt -= t * split_cols; if (act == 1 && t < act_from) a = 0; }
        const int col0 = colt + wc * 32 + 8 * fq;
#pragma unroll
        for (int ai = 0; ai < 2; ++ai)
#pragma unroll
            for (int m = 0; m < 4; ++m) { bf16_t* rowp = base + (size_t)(row0 + ai * HALF + m * 16) * ldc + col0;
#pragma unroll
                for (int bj = 0; bj < 2; ++bj) { f32x4 v0 = acc[ai][bj][m][0], v1 = acc[ai][bj][m][1];
                    if (a == 1) {
#pragma unroll
                        for (int e = 0; e < 4; ++e) { v0[e] = 1.0f / (1.0f + __expf(-v0[e])); v1[e] = 1.0f / (1.0f + __expf(-v1[e])); }
                    } else if (a == 2) {
#pragma unroll
                        for (int e = 0; e < 4; ++e) { float p = fmaxf(v0[e], 0.f), q = fmaxf(v1[e], 0.f); v0[e] = p * p; v1[e] = q * q; }
                    }
                    u32x4 w; w.x = cvt_pk_bf16(v0[0], v0[1]); w.y = cvt_pk_bf16(v0[2], v0[3]); w.z = cvt_pk_bf16(v1[0], v1[1]); w.w = cvt_pk_bf16(v1[2], v1[3]);
                    *(u32x4*)(rowp + bj * HALF) = w; } }
    }
};
struct EpiGate {
    static constexpr bool PERM = true, AFTER_DRAIN = false;
    const bf16_t* G; float* MG; bf16_t* MGb; int mode;
    __device__ __forceinline__ void operator()(const f32x4 (&acc)[2][2][4][2], const Unit& u, int wr, int wc, int fr, int fq) const {
        const int row0 = u.pm * BM + wr * 64 + fr; const int col0 = u.pn * BM + wc * 32 + 8 * fq;
#pragma unroll
        for (int ai = 0; ai < 2; ++ai)
#pragma unroll
            for (int m = 0; m < 4; ++m) { const size_t off = (size_t)(row0 + ai * HALF + m * 16) * 1024 + col0;
#pragma unroll
                for (int bj = 0; bj < 2; ++bj) { const size_t o2 = off + bj * HALF;
                    const u32x4 gw = *(const u32x4*)(G + o2);
                    f32x4 g0, g1;
                    g0[0] = __uint_as_float(gw.x << 16); g0[1] = __uint_as_float(gw.x & 0xffff0000u); g0[2] = __uint_as_float(gw.y << 16); g0[3] = __uint_as_float(gw.y & 0xffff0000u);
                    g1[0] = __uint_as_float(gw.z << 16); g1[1] = __uint_as_float(gw.z & 0xffff0000u); g1[2] = __uint_as_float(gw.w << 16); g1[3] = __uint_as_float(gw.w & 0xffff0000u);
                    f32x4 v0 = acc[ai][bj][m][0] * g0, v1 = acc[ai][bj][m][1] * g1;
                    if (mode != 0) { v0 = v0 + *(const f32x4*)(MG + o2); v1 = v1 + *(const f32x4*)(MG + o2 + 4); }
                    if (mode != 2) { *(f32x4*)(MG + o2) = v0; *(f32x4*)(MG + o2 + 4) = v1; }
                    else { u32x4 w; w.x = cvt_pk_bf16(v0[0], v0[1]); w.y = cvt_pk_bf16(v0[2], v0[3]); w.z = cvt_pk_bf16(v1[0], v1[1]); w.w = cvt_pk_bf16(v1[2], v1[3]); *(u32x4*)(MGb + o2) = w; } } }
    }
};
struct EpiRes {
    static constexpr bool PERM = false, AFTER_DRAIN = false;
    const float* base; float* out;
    __device__ __forceinline__ void operator()(const f32x4 (&acc)[2][2][4][2], const Unit& u, int wr, int wc, int fr, int fq) const {
        const int col0 = u.pn * BM + wc * 32 + 4 * fq;
#pragma unroll
        for (int ai = 0; ai < 2; ++ai)
#pragma unroll
            for (int m = 0; m < 4; ++m) { const size_t off = (size_t)(u.pm * BM + ai * HALF + wr * 64 + m * 16 + fr) * 1024 + col0;
#pragma unroll
                for (int bj = 0; bj < 2; ++bj)
#pragma unroll
                    for (int n = 0; n < 2; ++n) { const f32x4 bs = *(const f32x4*)(base + off + bj * HALF + n * 16); *(f32x4*)(out + off + bj * HALF + n * 16) = bs + acc[ai][bj][m][n]; } }
    }
};
}
constexpr int BATCH = 2, SEQ = 8192, DM = 1024, M = BATCH * SEQ, NIN = 13320, FF = 4096;
constexpr float EPS = 1e-6f;
constexpr float SB_THR = -45.0f;
constexpr size_t MiB = 1u << 20;
constexpr size_t WS_GATES = 1 * MiB;
constexpr size_t WS_MLOC = 1 * MiB + 512 * 1024, WS_BLAST = WS_MLOC + 4096, WS_MST = WS_BLAST + 4096;
constexpr size_t WS_WIN = 2 * MiB, WS_WML = 28 * MiB, WS_WSC = 30 * MiB, WS_WSB = 32 * MiB, WS_WOUT = 34 * MiB, WS_WUP = 36 * MiB, WS_WDN = 44 * MiB;
constexpr size_t WS_XN = 52 * MiB, WS_YML = 84 * MiB, WS_BIG = 116 * MiB;
constexpr size_t WS_PA = WS_BIG;
constexpr size_t WS_ST = 244 * MiB, WS_DN = 372 * MiB;
constexpr size_t WS_P2 = WS_BIG;
constexpr size_t WS_YSC = WS_XN, WS_YSB = WS_P2 + 3 * 32 * MiB;
constexpr size_t WS_MG = WS_BIG, WS_MGB = WS_BIG + 64 * MiB, WS_HB = WS_BIG + 96 * MiB;
constexpr size_t WS_END = 404 * MiB;
constexpr int LDS_BYTES = 147456;
constexpr int NPH = 12;

#ifndef PHMASK
#define PHMASK 0x1fff
#endif
#define LAS __attribute__((address_space(3)))
typedef unsigned short bf16;
typedef unsigned v4u __attribute__((ext_vector_type(4)));
typedef unsigned v2u __attribute__((ext_vector_type(2)));
typedef float f32x4 __attribute__((ext_vector_type(4)));
typedef short bf16x8 __attribute__((ext_vector_type(8)));
__device__ __forceinline__ float bflo(unsigned w) { return __uint_as_float(w << 16); }
__device__ __forceinline__ float bfhi(unsigned w) { return __uint_as_float(w & 0xffff0000u); }
__device__ __forceinline__ float bf2f(unsigned short h) { return __uint_as_float((unsigned)h << 16); }
typedef float f32x2_t __attribute__((ext_vector_type(2))); typedef __bf16 bf16x2_t __attribute__((ext_vector_type(2)));
__device__ __forceinline__ unsigned pk2(float lo, float hi) { f32x2_t v = {lo, hi}; bf16x2_t b = __builtin_convertvector(v, bf16x2_t); return __builtin_bit_cast(unsigned, b); }
__device__ __forceinline__ unsigned short f2bf(float f) { return (unsigned short)(pk2(f, 0.f) & 0xffffu); }
__device__ __forceinline__ float wave_sum(float v) {
#pragma unroll
    for (int o = 1; o < 64; o <<= 1) v += __shfl_xor(v, o);
    return v;
}
__device__ __forceinline__ float wave_max(float v) {
#pragma unroll
    for (int o = 1; o < 64; o <<= 1) v = fmaxf(v, __shfl_xor(v, o));
    return v;
}
__device__ __forceinline__ float wave_prefix(float v, int lane) {
#pragma unroll
    for (int o = 1; o < 64; o <<= 1) { const float n = __shfl_up(v, o); if (lane >= o) v += n; }
    return v;
}
__device__ __forceinline__ float log_sigmoid(float x) { return fminf(x, 0.f) - log1pf(expf(-fabsf(x))); }

struct Args { const float* in[14]; float* out; unsigned char* ws; int ph_lo, ph_hi; };

__device__ __forceinline__ void transpose_item(const float* W, int pitch, int ncols, int K, bf16* WT, int row_off, LAS float* scr, int item, int lane) {
    const int nblk = ncols / 32, kb = item / nblk, nb = item % nblk, k0 = 64 * kb, n0 = 32 * nb;
#pragma unroll 8
    for (int i = 0; i < 32; ++i) { const int kk = 2 * i + (lane >> 5); scr[kk * 33 + (lane & 31)] = W[(size_t)(k0 + kk) * pitch + n0 + (lane & 31)]; }
    asm volatile("s_waitcnt lgkmcnt(0)" ::: "memory");
    const int c = lane & 7;
#pragma unroll
    for (int j = 0; j < 4; ++j) { const int n = (lane >> 3) + 8 * j; const LAS float* s = scr + (8 * c) * 33 + n;
        v4u o; o.x = pk2(s[0 * 33], s[1 * 33]); o.y = pk2(s[2 * 33], s[3 * 33]); o.z = pk2(s[4 * 33], s[5 * 33]); o.w = pk2(s[6 * 33], s[7 * 33]);
        *(v4u*)(WT + (size_t)(row_off + n0 + n) * K + k0 + 8 * c) = o; }
    asm volatile("s_waitcnt lgkmcnt(0)" ::: "memory");
}

template <int MODE>
__device__ __forceinline__ void norm_row(const float* xrow, const float* gain, bf16* orow, float* frow, const LAS float* Wg, const float* bias, float* grow, int lane) {
    const f32x4* xr = (const f32x4*)xrow + lane; const f32x4* gr = (const f32x4*)gain + lane;
    f32x4 v[4]; float s = 0.f;
#pragma unroll
    for (int j = 0; j < 4; ++j) { v[j] = xr[64 * j]; s += (v[j].x * v[j].x + v[j].y * v[j].y) + (v[j].z * v[j].z + v[j].w * v[j].w); }
    const float rstd = 1.0f / sqrtf(wave_sum(s) * (1.0f / DM) + EPS);
#pragma unroll
    for (int j = 0; j < 4; ++j) v[j] = v[j] * rstd * gr[64 * j];
    if (MODE == 2) {
#pragma unroll
        for (int j = 0; j < 4; ++j) ((f32x4*)frow)[lane + 64 * j] = v[j];
    } else {
#pragma unroll
        for (int j = 0; j < 4; ++j) { v2u o; o.x = pk2(v[j].x, v[j].y); o.y = pk2(v[j].z, v[j].w); ((v2u*)orow)[lane + 64 * j] = o; }
    }
    if (MODE == 1) {
        float ga[8];
#pragma unroll
        for (int i = 0; i < 8; ++i) ga[i] = 0.f;
#pragma unroll
        for (int j = 0; j < 4; ++j)
#pragma unroll
            for (int e = 0; e < 4; ++e) { const int k = 4 * lane + 256 * j + e; const f32x4 a = *(const LAS f32x4*)(Wg + k * 8), b = *(const LAS f32x4*)(Wg + k * 8 + 4); const float x = v[j][e];
                ga[0] += x * a.x; ga[1] += x * a.y; ga[2] += x * a.z; ga[3] += x * a.w; ga[4] += x * b.x; ga[5] += x * b.y; ga[6] += x * b.z; ga[7] += x * b.w; }
#pragma unroll
        for (int i = 0; i < 8; ++i) ga[i] = wave_sum(ga[i]);
        if (lane == 0) {
            f32x4 o0 = {ga[0] + bias[0], ga[1] + bias[1], ga[2] + bias[2], ga[3] + bias[3]}, o1 = {ga[4] + bias[4], ga[5] + bias[5], ga[6] + bias[6], ga[7] + bias[7]};
            ((f32x4*)grow)[0] = o0; ((f32x4*)grow)[1] = o1; }
    }
}

__global__ void __launch_bounds__(512, 2) mega(Args args) {
    extern __shared__ __attribute__((aligned(16))) unsigned char lds[];
    cg::grid_group grid = cg::this_grid();
    typedef const Args __attribute__((address_space(4))) CArgs;
#define PH_INIT \
    CArgs* ap = (CArgs*)__builtin_amdgcn_kernarg_segment_ptr(); asm volatile("" : "+s"(ap)); \
    int tid = threadIdx.x; asm volatile("" : "+v"(tid)); \
    LAS unsigned char* L = (LAS unsigned char*)lds; \
    const int lane = tid & 63, wave = __builtin_amdgcn_readfirstlane(tid >> 6); \
    const int G = gridDim.x; const int bx = blockIdx.x; const int vcu = (G % 8 == 0) ? (bx % 8) * (G / 8) + bx / 8 : bx; \
    const int lr = lane & 15, lg = lane >> 4; \
    unsigned char* ws = ap->ws; float* out = ap->out; \
    float* GATES = (float*)(ws + WS_GATES); float* MLOC = (float*)(ws + WS_MLOC); float* BLAST = (float*)(ws + WS_BLAST); float* MST = (float*)(ws + WS_MST); \
    bf16* XN = (bf16*)(ws + WS_XN); bf16* YML = (bf16*)(ws + WS_YML); \
    bf16* ST = (bf16*)(ws + WS_ST); float* DN = (float*)(ws + WS_DN); \
    const size_t TS = (size_t)M * 1024; \
    bf16* PA = (bf16*)(ws + WS_PA); bf16* P2 = (bf16*)(ws + WS_P2); \
    (void)lane; (void)wave; (void)vcu; (void)lr; (void)lg; (void)out; (void)GATES; (void)MLOC; (void)BLAST; (void)MST; (void)XN; (void)YML; (void)ST; (void)DN; (void)TS; (void)PA; (void)P2; (void)L; (void)bx;
    int ph_lo, ph_hi;
    { CArgs* ap0 = (CArgs*)__builtin_amdgcn_kernarg_segment_ptr(); ph_lo = ap0->ph_lo; ph_hi = ap0->ph_hi; }

    for (int p = ph_lo; p < ph_hi; ++p) {
        if (p > ph_lo) grid.sync();
        const int l = p / NPH, k = (p == 2 * NPH) ? NPH : p % NPH;
        switch (k) {
        case 0: { if (!((PHMASK >> 0) & 1)) break; PH_INIT
            LAS float* scr = (LAS float*)(L + wave * 8704);
            const int gw = vcu * 8 + wave, NGW = G * 8;
            const float* win = ap->in[2] + (size_t)l * 1024 * NIN;
            for (int it = gw; it < 12800; it += NGW) {
                if (it < 6656) { const int grp = it >> 9, r = it & 511; const int coff = grp < 4 ? grp * 1024 : 4104 + (grp - 4) * 1024;
                    transpose_item(win + coff, NIN, 1024, 1024, (bf16*)(ws + WS_WIN), grp * 1024, scr, r, lane); }
                else if (it < 8704) { const int mi = (it - 6656) >> 9, r = (it - 6656) & 511;
                    transpose_item(ap->in[6 + mi] + (size_t)l * 1024 * 1024, 1024, 1024, 1024, (bf16*)(ws + WS_WML + (size_t)mi * 2 * MiB), 0, scr, r, lane); }
                else if (it < 10752) transpose_item(ap->in[11] + (size_t)l * 1024 * FF, FF, FF, 1024, (bf16*)(ws + WS_WUP), 0, scr, it - 8704, lane);
                else { const int sl = (it - 10752) >> 9, r = (it - 10752) & 511; transpose_item(ap->in[12] + (size_t)l * FF * 1024 + (size_t)sl * 1024 * 1024, 1024, 1024, 1024, (bf16*)(ws + WS_WDN + (size_t)sl * 2 * MiB), 0, scr, r, lane); }
            }
            LAS float* Wg = (LAS float*)(L + 73728);
            for (int i = tid; i < 8192; i += 512) Wg[i] = win[(size_t)(i >> 3) * NIN + 4096 + (i & 7)];
            __syncthreads();
            const float* xsrc = l == 0 ? ap->in[0] : out;
            for (int m = gw; m < M; m += NGW)
                norm_row<1>(xsrc + (size_t)m * DM, ap->in[1] + l * DM, XN + (size_t)m * DM, nullptr, Wg, ap->in[3] + l * 8, GATES + (size_t)m * 8, lane);
            __syncthreads();
        } break;
        case 1: case 5: case 10: {
            if (!((PHMASK >> k) & 1)) break; PH_INIT
            const bf16* Bt = k == 1 ? (const bf16*)(ws + WS_WIN) : (k == 5 ? (const bf16*)(ws + WS_WIN) + (size_t)4096 * 1024 : (const bf16*)(ws + WS_WUP));
            const int N = k == 1 ? 4096 : (k == 5 ? 9216 : FF);
            pg8::Gemm g{XN, Bt, M, N, 1024}; pg8::StaticOrder S; S.init(M, N, G, bx);
            pg8::EpiStore E{k == 10 ? (bf16*)(ws + WS_HB) : PA, 1024, 1024, TS, k == 1 ? 0 : (k == 5 ? 1 : 2), 6};
            pg8::gemm_phase<pg8::EpiStore, pg8::StaticOrder, true, true>((PG8_LAS unsigned char*)L, g, S, E);
        } break;
        case 8: case 11: {
            if (!((PHMASK >> k) & 1)) break; PH_INIT
            const int nrep = k == 8 ? 1 : 4;
#pragma unroll 1
            for (int j = 0; j < nrep; ++j) {
                const bf16* A = k == 8 ? (const bf16*)(ws + WS_MGB) : (const bf16*)(ws + WS_HB) + (size_t)j * TS;
                const bf16* Bt = k == 8 ? (const bf16*)(ws + WS_WOUT) : (const bf16*)(ws + WS_WDN) + (size_t)j * 1024 * 1024;
                pg8::Gemm g{A, Bt, M, 1024, 1024}; pg8::StaticOrder S; S.init(M, 1024, G, bx);
                pg8::EpiRes E{(k == 8 && l == 0) ? ap->in[0] : out, out};
                pg8::gemm_phase<pg8::EpiRes, pg8::StaticOrder, true, true>((PG8_LAS unsigned char*)L, g, S, E);
                __syncthreads();
            }
        } break;
        case 2: { if (!((PHMASK >> 2) & 1)) break; PH_INIT
            LAS bf16* KT = (LAS bf16*)L; LAS bf16* VT = (LAS bf16*)(L + 36864); LAS float* wS = (LAS float*)(L + 73728);
            for (int u = vcu; u < 1024; u += G) {
                const int bh = u >> 7, c = u & 127, b = bh >> 2, h = bh & 3; const size_t r0 = (size_t)b * SEQ + c * 64;
                if (wave == 0) {
                    const float ip = GATES[(r0 + lane) * 8 + h], fp = GATES[(r0 + lane) * 8 + 4 + h];
                    const float bc = wave_prefix(log_sigmoid(fp), lane); const float blast = __shfl(bc, 63);
                    const float gg = blast - bc + ip; const float mloc = wave_max(gg);
                    wS[lane] = expf(gg - mloc);
                    if (lane == 0) { MLOC[u] = mloc; BLAST[u] = blast; }
                }
                __syncthreads();
                for (int it = tid; it < 2048; it += 512) { const int s = it >> 5, d8 = it & 31; const size_t go = (r0 + s) * 1024 + h * 256 + d8 * 8;
                    const v4u kv = *(const v4u*)(PA + TS + go), vv = *(const v4u*)(PA + 2 * TS + go); const float w = wS[s];
                    LAS bf16* kt = KT + (d8 * 8) * 72 + s; LAS bf16* vt = VT + (d8 * 8) * 72 + s;
                    kt[0 * 72] = f2bf(bflo(kv.x) * 0.0625f); kt[1 * 72] = f2bf(bfhi(kv.x) * 0.0625f); kt[2 * 72] = f2bf(bflo(kv.y) * 0.0625f); kt[3 * 72] = f2bf(bfhi(kv.y) * 0.0625f);
                    kt[4 * 72] = f2bf(bflo(kv.z) * 0.0625f); kt[5 * 72] = f2bf(bfhi(kv.z) * 0.0625f); kt[6 * 72] = f2bf(bflo(kv.w) * 0.0625f); kt[7 * 72] = f2bf(bfhi(kv.w) * 0.0625f);
                    vt[0 * 72] = f2bf(bflo(vv.x) * w); vt[1 * 72] = f2bf(bfhi(vv.x) * w); vt[2 * 72] = f2bf(bflo(vv.y) * w); vt[3 * 72] = f2bf(bfhi(vv.y) * w);
                    vt[4 * 72] = f2bf(bflo(vv.z) * w); vt[5 * 72] = f2bf(bfhi(vv.z) * w); vt[6 * 72] = f2bf(bflo(vv.w) * w); vt[7 * 72] = f2bf(bfhi(vv.w) * w); }
                __syncthreads();
                if (tid < 256) { float a = 0.f;
#pragma unroll 8
                    for (int s = 0; s < 64; ++s) a += wS[s] * bf2f(KT[tid * 72 + s]);
                    DN[(size_t)u * 256 + tid] = a; }
                bf16* Cg = ST + (size_t)u * 65536;
#pragma unroll 1
                for (int mbi = 0; mbi < 2; ++mbi) { const int m0 = (wave * 2 + mbi) * 16;
                    const bf16x8 a0 = *(const LAS bf16x8*)(KT + (m0 + lr) * 72 + 8 * lg), a1 = *(const LAS bf16x8*)(KT + (m0 + lr) * 72 + 32 + 8 * lg);
#pragma unroll 4
                    for (int nb = 0; nb < 16; ++nb) {
                        const bf16x8 b0 = *(const LAS bf16x8*)(VT + (nb * 16 + lr) * 72 + 8 * lg), b1 = *(const LAS bf16x8*)(VT + (nb * 16 + lr) * 72 + 32 + 8 * lg);
                        f32x4 acc = {0.f, 0.f, 0.f, 0.f};
                        acc = __builtin_amdgcn_mfma_f32_16x16x32_bf16(a0, b0, acc, 0, 0, 0);
                        acc = __builtin_amdgcn_mfma_f32_16x16x32_bf16(a1, b1, acc, 0, 0, 0);
                        v2u o; o.x = pk2(acc[0], acc[1]); o.y = pk2(acc[2], acc[3]);
                        *(v2u*)(Cg + (size_t)(nb * 16 + lr) * 256 + m0 + 4 * lg) = o; } }
                __syncthreads();
            }
        } break;
        case 3: { if (!((PHMASK >> 3) & 1)) break; PH_INIT
            const int gt = vcu * 512 + tid, NT = G * 512;
            for (int q = gt; q < 131072; q += NT) {
                const int chain = q >> 14, e4 = q & 16383;
                unsigned long long* pp = (unsigned long long*)ST + (size_t)chain * 128 * 16384 + e4;
                float C0 = 0.f, C1 = 0.f, C2 = 0.f, C3 = 0.f, m = 0.f;
                unsigned long long cur[4], nxt[4];
#pragma unroll
                for (int j = 0; j < 4; ++j) cur[j] = pp[(size_t)j * 16384];
                for (int c = 0; c < 128; c += 4) {
                    if (c + 4 < 128) {
#pragma unroll
                        for (int j = 0; j < 4; ++j) nxt[j] = pp[(size_t)(c + 4 + j) * 16384];
                    }
#pragma unroll
                    for (int j = 0; j < 4; ++j) { const int u = chain * 128 + c + j; const float ml = MLOC[u], bl = BLAST[u];
                        if (e4 == 0) MST[u] = m;
                        const unsigned lo = pk2(C0, C1), hi = pk2(C2, C3);
                        pp[(size_t)(c + j) * 16384] = (unsigned long long)lo | ((unsigned long long)hi << 32);
                        const float mn = fmaxf(bl + m, ml), a = expf(bl + m - mn), bs = expf(ml - mn);
                        const unsigned dlo = (unsigned)cur[j], dhi = (unsigned)(cur[j] >> 32);
                        C0 = a * C0 + bs * bflo(dlo); C1 = a * C1 + bs * bfhi(dlo); C2 = a * C2 + bs * bflo(dhi); C3 = a * C3 + bs * bfhi(dhi); m = mn; }
#pragma unroll
                    for (int j = 0; j < 4; ++j) cur[j] = nxt[j];
                }
            }
            for (int q = gt; q < 2048; q += NT) {
                const int chain = q >> 8, kk = q & 255; float n = 0.f, m = 0.f;
                for (int c = 0; c < 128; ++c) { const int u = chain * 128 + c; const float ml = MLOC[u], bl = BLAST[u];
                    float* pn = DN + (size_t)u * 256 + kk; const float d = *pn; *pn = n;
                    const float mn = fmaxf(bl + m, ml); n = expf(bl + m - mn) * n + expf(ml - mn) * d; m = mn; }
            }
        } break;
        case 4: { if (!((PHMASK >> 4) & 1)) break; PH_INIT
            LAS bf16* Qs = (LAS bf16*)L; LAS bf16* Ks = (LAS bf16*)(L + 33792); LAS bf16* VT = (LAS bf16*)(L + 67584); LAS float* Sf = (LAS float*)(L + 104448);
            LAS bf16* Pb = Ks;
            LAS float* bcs = (LAS float*)(L + 121088); LAS float* ii = bcs + 64; LAS float* AI = bcs + 128; LAS float* DEN = bcs + 192; LAS float* SSQ = bcs + 256;
            for (int u = vcu; u < 1024; u += G) {
                const int bh = u >> 7, c = u & 127, b = bh >> 2, h = bh & 3; const size_t r0 = (size_t)b * SEQ + c * 64;
                if (wave == 0) {
                    const float ip = GATES[(r0 + lane) * 8 + h], fp = GATES[(r0 + lane) * 8 + 4 + h];
                    bcs[lane] = wave_prefix(log_sigmoid(fp), lane); ii[lane] = ip;
                }
                for (int it = tid; it < 2048; it += 512) { const int s = it >> 5, d8 = it & 31; const size_t go = (r0 + s) * 1024 + h * 256 + d8 * 8;
                    const v4u qv = *(const v4u*)(PA + go), kv = *(const v4u*)(PA + TS + go), vv = *(const v4u*)(PA + 2 * TS + go);
                    *(LAS v4u*)(Qs + s * 264 + d8 * 8) = qv;
                    v4u ks; ks.x = pk2(bflo(kv.x) * 0.0625f, bfhi(kv.x) * 0.0625f); ks.y = pk2(bflo(kv.y) * 0.0625f, bfhi(kv.y) * 0.0625f); ks.z = pk2(bflo(kv.z) * 0.0625f, bfhi(kv.z) * 0.0625f); ks.w = pk2(bflo(kv.w) * 0.0625f, bfhi(kv.w) * 0.0625f);
                    *(LAS v4u*)(Ks + s * 264 + d8 * 8) = ks;
                    LAS bf16* vt = VT + (d8 * 8) * 72 + s;
                    vt[0 * 72] = (bf16)(vv.x & 0xffffu); vt[1 * 72] = (bf16)(vv.x >> 16); vt[2 * 72] = (bf16)(vv.y & 0xffffu); vt[3 * 72] = (bf16)(vv.y >> 16);
                    vt[4 * 72] = (bf16)(vv.z & 0xffffu); vt[5 * 72] = (bf16)(vv.z >> 16); vt[6 * 72] = (bf16)(vv.w & 0xffffu); vt[7 * 72] = (bf16)(vv.w >> 16); }
                __syncthreads();
                {
                    const int tb = wave >> 1;
#pragma unroll
                    for (int sbi = 0; sbi < 2; ++sbi) { const int sb = (wave & 1) * 2 + sbi; f32x4 acc = {0.f, 0.f, 0.f, 0.f};
#pragma unroll
                        for (int kk = 0; kk < 8; ++kk) { const bf16x8 a = *(const LAS bf16x8*)(Qs + (tb * 16 + lr) * 264 + kk * 32 + 8 * lg), bb = *(const LAS bf16x8*)(Ks + (sb * 16 + lr) * 264 + kk * 32 + 8 * lg);
                            acc = __builtin_amdgcn_mfma_f32_16x16x32_bf16(a, bb, acc, 0, 0, 0); }
#pragma unroll
                        for (int r = 0; r < 4; ++r) Sf[(tb * 16 + 4 * lg + r) * 65 + sb * 16 + lr] = acc[r]; }
                }
                __syncthreads();
                {
                    const int t = tid >> 3, part = tid & 7; const float mc = MST[u], bt = bcs[t];
                    float d[8]; float mx = -INFINITY;
#pragma unroll
                    for (int j = 0; j < 8; ++j) { const int s = part * 8 + j; d[j] = (s <= t) ? (bt - bcs[s] + ii[s]) : -INFINITY; mx = fmaxf(mx, d[j]); }
                    mx = fmaxf(mx, __shfl_xor(mx, 1)); mx = fmaxf(mx, __shfl_xor(mx, 2)); mx = fmaxf(mx, __shfl_xor(mx, 4));
                    const float inter = bt + mc, mt = fmaxf(inter, mx);
                    float rs = 0.f; unsigned pw[4];
#pragma unroll
                    for (int j = 0; j < 8; j += 2) { const int s = part * 8 + j;
                        const float p0 = (s <= t) ? Sf[t * 65 + s] * expf(d[j] - mt) : 0.f, p1 = (s + 1 <= t) ? Sf[t * 65 + s + 1] * expf(d[j + 1] - mt) : 0.f;
                        rs += p0 + p1; pw[j >> 1] = pk2(p0, p1); }
                    v4u pv; pv.x = pw[0]; pv.y = pw[1]; pv.z = pw[2]; pv.w = pw[3];
                    rs += __shfl_xor(rs, 1); rs += __shfl_xor(rs, 2); rs += __shfl_xor(rs, 4);
                    float dq = 0.f; const float* dn = DN + (size_t)u * 256 + part * 32;
#pragma unroll 8
                    for (int kk = 0; kk < 32; ++kk) dq += bf2f(Qs[t * 264 + part * 32 + kk]) * dn[kk];
                    dq += __shfl_xor(dq, 1); dq += __shfl_xor(dq, 2); dq += __shfl_xor(dq, 4);
                    const float ai = expf(inter - mt);
                    *(LAS v4u*)(Pb + t * 72 + part * 8) = pv;
                    if (part == 0) { AI[t] = ai; DEN[t] = fmaxf(fabsf(rs + ai * dq), expf(-mt)); }
                }
                __syncthreads();
                {
                    f32x4 acc[4][2];
#pragma unroll
                    for (int tb = 0; tb < 4; ++tb) { acc[tb][0] = (f32x4){0.f, 0.f, 0.f, 0.f}; acc[tb][1] = (f32x4){0.f, 0.f, 0.f, 0.f}; }
                    const bf16* Cg = ST + (size_t)u * 65536;
#pragma unroll 2
                    for (int kk = 0; kk < 8; ++kk) {
                        bf16x8 bfr[2];
#pragma unroll
                        for (int nbi = 0; nbi < 2; ++nbi) bfr[nbi] = *(const bf16x8*)(Cg + (size_t)((wave * 2 + nbi) * 16 + lr) * 256 + kk * 32 + 8 * lg);
#pragma unroll
                        for (int tb = 0; tb < 4; ++tb) { const bf16x8 a = *(const LAS bf16x8*)(Qs + (tb * 16 + lr) * 264 + kk * 32 + 8 * lg);
                            acc[tb][0] = __builtin_amdgcn_mfma_f32_16x16x32_bf16(a, bfr[0], acc[tb][0], 0, 0, 0);
                            acc[tb][1] = __builtin_amdgcn_mfma_f32_16x16x32_bf16(a, bfr[1], acc[tb][1], 0, 0, 0); }
                    }
#pragma unroll
                    for (int tb = 0; tb < 4; ++tb)
#pragma unroll
                        for (int r = 0; r < 4; ++r) { const float ai = AI[tb * 16 + 4 * lg + r]; acc[tb][0][r] *= ai; acc[tb][1][r] *= ai; }
#pragma unroll
                    for (int kk = 0; kk < 2; ++kk) {
                        bf16x8 bfr[2];
#pragma unroll
                        for (int nbi = 0; nbi < 2; ++nbi) bfr[nbi] = *(const LAS bf16x8*)(VT + ((wave * 2 + nbi) * 16 + lr) * 72 + kk * 32 + 8 * lg);
#pragma unroll
                        for (int tb = 0; tb < 4; ++tb) { const bf16x8 a = *(const LAS bf16x8*)(Pb + (tb * 16 + lr) * 72 + kk * 32 + 8 * lg);
                            acc[tb][0] = __builtin_amdgcn_mfma_f32_16x16x32_bf16(a, bfr[0], acc[tb][0], 0, 0, 0);
                            acc[tb][1] = __builtin_amdgcn_mfma_f32_16x16x32_bf16(a, bfr[1], acc[tb][1], 0, 0, 0); }
                    }
                    const bf16* Og = PA + 3 * TS;
#pragma unroll
                    for (int tb = 0; tb < 4; ++tb)
#pragma unroll
                        for (int r = 0; r < 4; ++r) { const int t = tb * 16 + 4 * lg + r; const float inv = 1.0f / DEN[t]; float sq = 0.f;
#pragma unroll
                            for (int nbi = 0; nbi < 2; ++nbi) { const int v = (wave * 2 + nbi) * 16 + lr; const float og = bf2f(Og[(r0 + t) * 1024 + h * 256 + v]);
                                const float y = acc[tb][nbi][r] * inv * (1.0f / (1.0f + __expf(-og))); acc[tb][nbi][r] = y; sq += y * y; }
                            sq += __shfl_xor(sq, 1); sq += __shfl_xor(sq, 2); sq += __shfl_xor(sq, 4); sq += __shfl_xor(sq, 8);
                            if (lr == 0) SSQ[wave * 64 + t] = sq; }
                    __syncthreads();
                    const float* gn = ap->in[4] + l * 1024 + h * 256;
#pragma unroll
                    for (int tb = 0; tb < 4; ++tb)
#pragma unroll
                        for (int r = 0; r < 4; ++r) { const int t = tb * 16 + 4 * lg + r; float tot = 0.f;
#pragma unroll
                            for (int w = 0; w < 8; ++w) tot += SSQ[w * 64 + t];
                            const float rstd = 1.0f / sqrtf(tot * (1.0f / 256.0f) + EPS);
#pragma unroll
                            for (int nbi = 0; nbi < 2; ++nbi) { const int v = (wave * 2 + nbi) * 16 + lr; YML[(r0 + t) * 1024 + h * 256 + v] = f2bf(acc[tb][nbi][r] * rstd * gn[v]); } }
                }
                __syncthreads();
            }
        } break;
        case 6: { if (!((PHMASK >> 6) & 1)) break; PH_INIT
            {
                const bf16* SCB = P2; const bf16* SCC = P2 + TS; const bf16* SCU = P2 + 2 * TS; bf16* YSC = (bf16*)(ws + WS_YSC);
                const float* cw = ap->in[5] + (size_t)l * 3 * 1024;
                for (int it = vcu * 512 + tid; it < M * 128; it += G * 512) { const int row = it >> 7, c8 = it & 127, t = row & (SEQ - 1); const size_t o = (size_t)row * 1024 + c8 * 8;
                    const v4u bv = *(const v4u*)(SCB + o), c0 = *(const v4u*)(SCC + o), u0 = *(const v4u*)(SCU + o);
                    v4u c1 = {0u, 0u, 0u, 0u}, u1 = c1, c2 = c1, u2 = c1;
                    if (t >= 1) { c1 = *(const v4u*)(SCC + o - 1024); u1 = *(const v4u*)(SCU + o - 1024); }
                    if (t >= 2) { c2 = *(const v4u*)(SCC + o - 2048); u2 = *(const v4u*)(SCU + o - 2048); }
                    const f32x4 w0a = *(const f32x4*)(cw + c8 * 8), w0b = *(const f32x4*)(cw + c8 * 8 + 4), w1a = *(const f32x4*)(cw + 1024 + c8 * 8), w1b = *(const f32x4*)(cw + 1024 + c8 * 8 + 4),
                                w2a = *(const f32x4*)(cw + 2048 + c8 * 8), w2b = *(const f32x4*)(cw + 2048 + c8 * 8 + 4);
                    v4u ov;
#define CONV2(F, WA, E0, E1) pk2(bflo(bv.F) * (WA##0[E0] * bflo(c2.F) * bflo(u2.F) + WA##1[E0] * bflo(c1.F) * bflo(u1.F) + WA##2[E0] * bflo(c0.F) * bflo(u0.F)), \
                                 bfhi(bv.F) * (WA##0[E1] * bfhi(c2.F) * bfhi(u2.F) + WA##1[E1] * bfhi(c1.F) * bfhi(u1.F) + WA##2[E1] * bfhi(c0.F) * bfhi(u0.F)))
                    const f32x4 wa0 = w0a, wa1 = w1a, wa2 = w2a, wb0 = w0b, wb1 = w1b, wb2 = w2b;
                    ov.x = CONV2(x, wa, 0, 1); ov.y = CONV2(y, wa, 2, 3); ov.z = CONV2(z, wb, 0, 1); ov.w = CONV2(w, wb, 2, 3);
#undef CONV2
                    *(v4u*)(YSC + o) = ov; }
            }
            {
                bf16* SBQ = P2 + 3 * TS; const bf16* SBK = P2 + 4 * TS; const bf16* SBV = P2 + 5 * TS;
                for (int wu = vcu * 8 + wave; wu < 4096; wu += G * 8) {
                    const int bh = wu >> 7, qt = wu & 127, b = bh >> 4, h = bh & 15, q0 = qt * 64, t = q0 + lane;
                    float q[64], o[64];
                    { const v4u* qp = (const v4u*)(SBQ + ((size_t)b * SEQ + t) * 1024 + h * 64);
#pragma unroll
                      for (int j = 0; j < 8; ++j) { const v4u w = qp[j]; q[8 * j] = bflo(w.x) * 0.125f; q[8 * j + 1] = bfhi(w.x) * 0.125f; q[8 * j + 2] = bflo(w.y) * 0.125f; q[8 * j + 3] = bfhi(w.y) * 0.125f;
                          q[8 * j + 4] = bflo(w.z) * 0.125f; q[8 * j + 5] = bfhi(w.z) * 0.125f; q[8 * j + 6] = bflo(w.w) * 0.125f; q[8 * j + 7] = bfhi(w.w) * 0.125f; } }
#pragma unroll
                    for (int j = 0; j < 64; ++j) o[j] = 0.f;
                    float R = 0.f;
                    for (int s = q0 + 62; s >= 0; --s) {
                        const size_t ko = ((size_t)b * SEQ + s) * 1024 + h * 64;
                        const v4u* kp = (const v4u*)(SBK + ko); const v4u* vp = (const v4u*)(SBV + ko);
                        float z0 = 0.f, z1 = 0.f;
#pragma unroll
                        for (int j = 0; j < 8; ++j) { const v4u w = kp[j];
                            z0 += q[8 * j] * bflo(w.x); z1 += q[8 * j + 1] * bfhi(w.x); z0 += q[8 * j + 2] * bflo(w.y); z1 += q[8 * j + 3] * bfhi(w.y);
                            z0 += q[8 * j + 4] * bflo(w.z); z1 += q[8 * j + 5] * bfhi(w.z); z0 += q[8 * j + 6] * bflo(w.w); z1 += q[8 * j + 7] * bfhi(w.w); }
                        const float z = z0 + z1; const bool act = s < t;
                        const float sp = fmaxf(z, 0.f) + __logf(1.0f + __expf(-fabsf(z)));
                        const float a = act ? __expf(z - sp + R) : 0.f;
                        R -= act ? sp : 0.f;
#pragma unroll
                        for (int j = 0; j < 8; ++j) { const v4u w = vp[j];
                            o[8 * j] += a * bflo(w.x); o[8 * j + 1] += a * bfhi(w.x); o[8 * j + 2] += a * bflo(w.y); o[8 * j + 3] += a * bfhi(w.y);
                            o[8 * j + 4] += a * bflo(w.z); o[8 * j + 5] += a * bfhi(w.z); o[8 * j + 6] += a * bflo(w.w); o[8 * j + 7] += a * bfhi(w.w); }
                        if (s <= q0 && __all(R < SB_THR)) break;
                    }
                    { v4u* op = (v4u*)(SBQ + ((size_t)b * SEQ + t) * 1024 + h * 64);
#pragma unroll
                      for (int j = 0; j < 8; ++j) { v4u w; w.x = pk2(o[8 * j], o[8 * j + 1]); w.y = pk2(o[8 * j + 2], o[8 * j + 3]); w.z = pk2(o[8 * j + 4], o[8 * j + 5]); w.w = pk2(o[8 * j + 6], o[8 * j + 7]); op[j] = w; } }
                }
            }
        } break;
        case 7: { if (!((PHMASK >> 7) & 1)) break; PH_INIT
#pragma unroll 1
            for (int i = 0; i < 3; ++i) {
                const bf16* A = i == 0 ? YML : (i == 1 ? (const bf16*)(ws + WS_YSC) : (const bf16*)(ws + WS_YSB));
                pg8::Gemm g{A, (const bf16*)(ws + WS_WML + (size_t)i * 2 * MiB), M, 1024, 1024}; pg8::StaticOrder S; S.init(M, 1024, G, bx);
                pg8::EpiGate E{P2 + (size_t)(6 + i) * TS, (float*)(ws + WS_MG), (bf16*)(ws + WS_MGB), i};
                pg8::gemm_phase<pg8::EpiGate, pg8::StaticOrder, true, true>((PG8_LAS unsigned char*)L, g, S, E);
                __syncthreads();
            }
        } break;
        case 9: { if (!((PHMASK >> 9) & 1)) break; PH_INIT
            const int gw = vcu * 8 + wave, NGW = G * 8;
            for (int m = gw; m < M; m += NGW) norm_row<0>(out + (size_t)m * DM, ap->in[10] + l * DM, XN + (size_t)m * DM, nullptr, nullptr, nullptr, nullptr, lane);
        } break;
        default: { if (!((PHMASK >> 12) & 1)) break; PH_INIT
            const int gw = vcu * 8 + wave, NGW = G * 8;
            for (int m = gw; m < M; m += NGW) norm_row<2>(out + (size_t)m * DM, ap->in[13], nullptr, out + (size_t)m * DM, nullptr, nullptr, nullptr, lane);
        } break;
        }
    }
}

#ifndef MK_PER_PHASE
#define MK_PER_PHASE 0
#endif
extern "C" void kernel_launch(void* const* d_in, const int* in_sizes, int n_in, void* d_out, int out_size, void* d_ws, size_t ws_size, hipStream_t stream) {
    static int grid = 0;
    if (grid == 0) {
        if (n_in != 14 || out_size != M * DM || ws_size < WS_END) { fprintf(stderr, "kernel_launch: unexpected shapes (n_in %d, out %d, ws %zu)\n", n_in, out_size, ws_size); grid = -1; return; }
        int dev = 0, cus = 0, per_cu = 0;
        hipGetDevice(&dev); hipDeviceGetAttribute(&cus, hipDeviceAttributeMultiprocessorCount, dev);
        if (hipFuncSetAttribute((const void*)mega, hipFuncAttributeMaxDynamicSharedMemorySize, LDS_BYTES) != hipSuccess) { fprintf(stderr, "kernel_launch: hipFuncSetAttribute failed\n"); grid = -1; return; }
        if (hipOccupancyMaxActiveBlocksPerMultiprocessor(&per_cu, (const void*)mega, 512, LDS_BYTES) != hipSuccess || per_cu < 1) { fprintf(stderr, "kernel_launch: occupancy query gave %d\n", per_cu); per_cu = 1; }
        (void)hipGetLastError();
        grid = cus * 1;
        fprintf(stderr, "kernel_launch: cus %d per_cu %d grid %d\n", cus, per_cu, grid);
    }
    if (grid < 0) return;
    Args a{};
    for (int i = 0; i < 14; ++i) a.in[i] = (const float*)d_in[i];
    a.out = (float*)d_out; a.ws = (unsigned char*)d_ws;
#if MK_PER_PHASE
    for (int p = 0; p < 2 * NPH + 1; ++p) { a.ph_lo = p; a.ph_hi = p + 1; hipLaunchKernelGGL(mega, dim3(grid), dim3(512), LDS_BYTES, stream, a); }
#else
    a.ph_lo = 0; a.ph_hi = 2 * NPH + 1;
    void* kargs[] = {&a};
    hipError_t e = hipLaunchCooperativeKernel((const void*)mega, dim3(grid), dim3(512), kargs, LDS_BYTES, stream);
    if (e != hipSuccess) fprintf(stderr, "kernel_launch: cooperative launch failed: %s (grid %d)\n", hipGetErrorString(e), grid);
#endif
}
```

```cpp
#include <hip/hip_runtime.h>
#include <hip/hip_cooperative_groups.h>
#include <cstdio>
#include <cstdint>
namespace cg = cooperative_groups;
namespace pg8 {
#define PG8_LAS __attribute__((address_space(3)))
typedef unsigned short bf16_t;
typedef short bf16x8 __attribute__((ext_vector_type(8)));
typedef float f32x4 __attribute__((ext_vector_type(4)));
typedef unsigned u32x4 __attribute__((ext_vector_type(4)));
constexpr int BM = 256, BK = 64, HALF = 128, HTB = HALF * BK * 2  , STAGE_BYTES = 8 * HTB, NXCD = 8, WGM = 4;

__host__ __device__ __forceinline__ int lds_byte(int r, int c) { const int st = (r >> 4) * 2 + (c >> 5), rr = r & 15, cc = c & 31, ob = rr * 64 + cc * 2; return st * 1024 + (ob ^ (((ob >> 9) & 1) << 5)); }
__host__ __device__ __forceinline__ void stage_rc(int b, int& R, int& C) { const int st = b / 1024, sb = b % 1024, swz = sb ^ (((sb >> 9) & 1) << 5); R = (st >> 1) * 16 + swz / 64; C = (st & 1) * 32 + (swz % 64) / 2; }
__host__ __device__ __forceinline__ int perm32(int rho) { const int n = rho >> 4, i = rho & 15; return 8 * (i >> 2) + 4 * n + (i & 3); }

struct Unit { int pm, pn; };
struct Gemm { const bf16_t* A; const bf16_t* Bt; int M, N, K; };

struct StaticOrder {
    int nM, nN, nwg, G, c;
    __host__ __device__ void init(int M, int N, int G_, int c_) { nM = M / BM; nN = N / BM; nwg = nM * nN; G = G_; c = c_; }
    __host__ __device__ bool next(int i, Unit& u) const {
        const long L = (long)i * G + c; if (L >= nwg) return false;
        int wgid = (int)L; { const int q = nwg / NXCD, r = nwg % NXCD, xcd = wgid % NXCD, off = wgid / NXCD; wgid = (xcd < r ? xcd * (q + 1) : r * (q + 1) + (xcd - r) * q) + off; }
        const int nig = WGM * nN, gid = wgid / nig, fm = gid * WGM, gsz = (nM - fm) < WGM ? (nM - fm) : WGM;
        u.pm = fm + ((wgid % nig) % gsz); u.pn = (wgid % nig) / gsz; return true;
    }
    __device__ __forceinline__ void a_ready(const Unit&) const {}
    __device__ __forceinline__ void done(const Unit&) const {}
};

__device__ __forceinline__ unsigned cvt_pk_bf16(float lo, float hi) { unsigned r; asm volatile("v_cvt_pk_bf16_f32 %0, %1, %2" : "=v"(r) : "v"(lo), "v"(hi)); return r; }
typedef float f32x2 __attribute__((ext_vector_type(2)));
__device__ __forceinline__ f32x2 gelu_pk(f32x2 v) {
    const f32x2 av = __builtin_elementwise_abs(v), d = av * 0.2316418882f + 1.0f;
    f32x2 t; t.x = __builtin_amdgcn_rcpf(d.x); t.y = __builtin_amdgcn_rcpf(d.y);
    f32x2 q = t * 0.5307027145f + (-0.7265760135f); q = q * t + 0.7107068705f; q = q * t + (-0.142248368f); q = q * t + 0.127414796f; q = q * t;
    const f32x2 s = (v * v) * (-0.72134752044f);
    f32x2 e; e.x = __builtin_amdgcn_exp2f(s.x); e.y = __builtin_amdgcn_exp2f(s.y);
    const f32x2 m = v * (q * e), r = v - m;
    f32x2 o; o.x = v.x < 0.f ? m.x : r.x; o.y = v.y < 0.f ? m.y : r.y; return o;
}

template <int ACT  > struct EpiBf16 {
    static constexpr bool PERM = true, AFTER_DRAIN = false; static_assert(ACT == 0 || ACT == 1, "EpiBf16: ACT is 0 (none) or 1 (gelu_pk)");
    bf16_t* O; int ldc; const float* bias; int split_cols; size_t split_stride; float scale0;
    __device__ __forceinline__ void operator()(const f32x4 (&acc)[2][2][4][2], const Unit& u, int wr, int wc, int fr, int fq) const {
        const int row0 = u.pm * BM + wr * 64 + fr; int colt = u.pn * BM; bf16_t* base = O;
        float sc = 1.f; if (split_cols) { const int t = colt / split_cols; base += (size_t)t * split_stride; colt -= t * split_cols; if (t == 0) sc = scale0; }
        const int col0 = colt + wc * 32 + 8 * fq, bcol0 = u.pn * BM + wc * 32 + 8 * fq;
        f32x4 bv[2][2];
#pragma unroll
        for (int bj = 0; bj < 2; ++bj)
#pragma unroll
            for (int n = 0; n < 2; ++n) bv[bj][n] = bias ? *(const f32x4*)(bias + bcol0 + bj * HALF + 4 * n) : (f32x4){0.f, 0.f, 0.f, 0.f};
#pragma unroll
        for (int ai = 0; ai < 2; ++ai)
#pragma unroll
            for (int m = 0; m < 4; ++m) { bf16_t* rowp = base + (size_t)(row0 + ai * HALF + m * 16) * ldc + col0;
#pragma unroll
                for (int bj = 0; bj < 2; ++bj) { f32x4 v0 = acc[ai][bj][m][0] + bv[bj][0], v1 = acc[ai][bj][m][1] + bv[bj][1];
                    if (ACT == 1) { f32x2 a = gelu_pk((f32x2){v0[0], v0[1]}), b = gelu_pk((f32x2){v0[2], v0[3]}), c = gelu_pk((f32x2){v1[0], v1[1]}), d = gelu_pk((f32x2){v1[2], v1[3]});
                        v0 = (f32x4){a.x, a.y, b.x, b.y}; v1 = (f32x4){c.x, c.y, d.x, d.y}; }
                    v0 = v0 * sc; v1 = v1 * sc; u32x4 w; w.x = cvt_pk_bf16(v0[0], v0[1]); w.y = cvt_pk_bf16(v0[2], v0[3]); w.z = cvt_pk_bf16(v1[0], v1[1]); w.w = cvt_pk_bf16(v1[2], v1[3]);
                    *(u32x4*)(rowp + bj * HALF) = w; } }
    }
};

struct PanelStats {
    unsigned* xbuf;
    unsigned* cnt;
    unsigned* tmo;
    int ntn; float eps;
    unsigned code;
    __device__ __forceinline__ bool run(const f32x4 (&v)[2][2][4][2], const Unit& u, int wr, int wc, int fr, int fq, PG8_LAS unsigned char* lds, int wid, int lane) const {
        typedef float f32x2v __attribute__((ext_vector_type(2)));
        PG8_LAS f32x2v* P = (PG8_LAS f32x2v*)lds;
        PG8_LAS f32x2v* S = (PG8_LAS f32x2v*)(lds + 8192);
        PG8_LAS unsigned* flag = (PG8_LAS unsigned*)(lds + 8192 + 2048);
#pragma unroll
        for (int ai = 0; ai < 2; ++ai)
#pragma unroll
            for (int m = 0; m < 4; ++m) {
                float s = 0.f;
#pragma unroll
                for (int bj = 0; bj < 2; ++bj)
#pragma unroll
                    for (int n = 0; n < 2; ++n) { const f32x4 x = v[ai][bj][m][n]; s += (x[0] + x[1]) + (x[2] + x[3]); }
                s += __shfl_xor(s, 16); s += __shfl_xor(s, 32);
                const float mw = s * (1.0f / 64.0f); float q = 0.f;
#pragma unroll
                for (int bj = 0; bj < 2; ++bj)
#pragma unroll
                    for (int n = 0; n < 2; ++n) { const f32x4 d = v[ai][bj][m][n] - mw; q += (d[0] * d[0] + d[1] * d[1]) + (d[2] * d[2] + d[3] * d[3]); }
                q += __shfl_xor(q, 16); q += __shfl_xor(q, 32);
                if (fq == 0) P[(ai * HALF + wr * 64 + m * 16 + fr) * 4 + wc] = (f32x2v){mw, q};
            }
        asm volatile("s_waitcnt lgkmcnt(0)" ::: "memory"); __builtin_amdgcn_s_barrier(); asm volatile("" ::: "memory");
#if defined(BROKEN_EXCHANGE_NO_WAIT)
#warning BROKEN CONTROL BUILD: the row-statistics exchange does not wait; results are wrong by design
        if (blockIdx.x >= 64) { const long long t0_ = clock64(); while (clock64() - t0_ < 60000) __builtin_amdgcn_s_sleep(8); }
#endif
        const int row = wid * 32 + (lane & 31);
        if (lane < 32) {
            const f32x2v a = P[row * 4 + 0], b = P[row * 4 + 1], c = P[row * 4 + 2], d = P[row * 4 + 3];
            const float mt = (a.x + b.x + c.x + d.x) * 0.25f;
            const float da = a.x - mt, db = b.x - mt, dc = c.x - mt, dd = d.x - mt;
            const float m2 = (a.y + b.y) + (c.y + d.y) + 64.0f * ((da * da + db * db) + (dc * dc + dd * dd));
            unsigned long long* slot = (unsigned long long*)xbuf + ((size_t)(u.pm * BM + row) * 4 + u.pn);
            __hip_atomic_store(slot, ((unsigned long long)__float_as_uint(m2) << 32) | __float_as_uint(mt), __ATOMIC_RELAXED, __HIP_MEMORY_SCOPE_AGENT);
        }
        asm volatile("s_waitcnt vmcnt(0)" ::: "memory");
        if (lane == 0) __hip_atomic_fetch_add(cnt + 64 * u.pm, 1u, __ATOMIC_RELAXED, __HIP_MEMORY_SCOPE_AGENT);
        if (wid == 0) {
            bool dead = false; const unsigned long long t0 = __builtin_amdgcn_s_memrealtime(); const unsigned want = 8u * (unsigned)ntn;
            for (;;) {
#if defined(BROKEN_EXCHANGE_NO_WAIT)
                break;
#endif
                if ((unsigned)__builtin_amdgcn_readfirstlane(__hip_atomic_load(cnt + 64 * u.pm, __ATOMIC_RELAXED, __HIP_MEMORY_SCOPE_AGENT)) >= want) break;
                if (__builtin_amdgcn_s_memrealtime() - t0 > 2000000ull) {
                    if (lane == 0) { unsigned expect = 0u; __hip_atomic_compare_exchange_strong(tmo + 1, &expect, code | (unsigned)(u.pm & 0xff), __ATOMIC_RELAXED, __ATOMIC_RELAXED, __HIP_MEMORY_SCOPE_AGENT);
                                     __hip_atomic_store(tmo, 1u, __ATOMIC_RELAXED, __HIP_MEMORY_SCOPE_AGENT); }
                    dead = true; break; }
                __builtin_amdgcn_s_sleep(2);
            }
            __builtin_amdgcn_fence(__ATOMIC_ACQUIRE, "agent");
            if (lane == 0) flag[0] = dead ? 1u : 0u;
        }
        asm volatile("s_waitcnt vmcnt(0) lgkmcnt(0)" ::: "memory"); __builtin_amdgcn_s_barrier(); asm volatile("" ::: "memory");
        const bool bad = flag[0] != 0u;
        if (lane < 32) {
            const unsigned long long* slot = (const unsigned long long*)xbuf + (size_t)(u.pm * BM + row) * 4; float mt[4], m2[4]; float ms = 0.f;
#pragma unroll
            for (int t = 0; t < 4; ++t) { if (t < ntn) { const unsigned long long w = __hip_atomic_load(slot + t, __ATOMIC_RELAXED, __HIP_MEMORY_SCOPE_AGENT); mt[t] = __uint_as_float((unsigned)w); m2[t] = __uint_as_float((unsigned)(w >> 32)); } else { mt[t] = 0.f; m2[t] = 0.f; } ms += mt[t]; }
            const float mean = ms / (float)ntn; float q = 0.f;
#pragma unroll
            for (int t = 0; t < 4; ++t) if (t < ntn) { const float dm = mt[t] - mean; q += m2[t] + 256.0f * dm * dm; }
            S[row] = (f32x2v){mean, 1.0f / sqrtf(q / (256.0f * (float)ntn) + eps)};
        }
        asm volatile("s_waitcnt lgkmcnt(0)" ::: "memory"); __builtin_amdgcn_s_barrier(); asm volatile("" ::: "memory");
        return bad;
    }
};
struct EpiLnRes {
    static constexpr bool PERM = false, AFTER_DRAIN = true;
    const float* base; float* out; int ldc; const float* bias; PanelStats st; unsigned poison;
    __device__ __forceinline__ void fused(f32x4 (&acc)[2][2][4][2], const Unit& u, int wr, int wc, int fr, int fq, PG8_LAS unsigned char* lds, int wid, int lane) const {
        typedef float f32x2v __attribute__((ext_vector_type(2)));
        const PG8_LAS f32x2v* S = (const PG8_LAS f32x2v*)(lds + 8192);
        const int col0 = u.pn * BM + wc * 32 + 4 * fq;
#pragma unroll
        for (int bj = 0; bj < 2; ++bj)
#pragma unroll
            for (int n = 0; n < 2; ++n) { const f32x4 bv = bias ? *(const f32x4*)(bias + col0 + bj * HALF + n * 16) : (f32x4){0.f, 0.f, 0.f, 0.f};
#pragma unroll
                for (int ai = 0; ai < 2; ++ai)
#pragma unroll
                    for (int m = 0; m < 4; ++m) acc[ai][bj][m][n] += bv; }
        f32x4 pre[4][2][2];
#pragma unroll
        for (int m = 0; m < 4; ++m) { const size_t off = (size_t)(u.pm * BM + wr * 64 + m * 16 + fr) * ldc + col0;
#pragma unroll
            for (int bj = 0; bj < 2; ++bj)
#pragma unroll
                for (int n = 0; n < 2; ++n) pre[m][bj][n] = *(const f32x4*)(base + off + bj * HALF + n * 16); }
        const bool bad = st.run(acc, u, wr, wc, fr, fq, lds, wid, lane) || poison != 0u;
        const float qnan = __builtin_nanf("");
#pragma unroll
        for (int ai = 0; ai < 2; ++ai)
#pragma unroll
            for (int m = 0; m < 4; ++m) { const int r = ai * HALF + wr * 64 + m * 16 + fr; const f32x2v sr = S[r]; const size_t off = (size_t)(u.pm * BM + r) * ldc + col0;
#pragma unroll
                for (int bj = 0; bj < 2; ++bj)
#pragma unroll
                    for (int n = 0; n < 2; ++n) { const f32x4 bs = ai == 0 ? pre[m][bj][n] : *(const f32x4*)(base + off + bj * HALF + n * 16); f32x4 o = bs + (acc[ai][bj][m][n] - sr.x) * sr.y;
                        if (bad) o = (f32x4){qnan, qnan, qnan, qnan}; *(f32x4*)(out + off + bj * HALF + n * 16) = o; }
                if (m & 1) asm volatile("" ::: "memory"); }
    }
};
struct EpiLnResLn {
    static constexpr bool PERM = false, AFTER_DRAIN = true;
    const float* base; float* out; bf16_t* xn; int ldc; const float* bias; PanelStats st1, st2; unsigned poison;
    __device__ __forceinline__ void fused(f32x4 (&acc)[2][2][4][2], const Unit& u, int wr, int wc, int fr, int fq, PG8_LAS unsigned char* lds, int wid, int lane) const {
        typedef float f32x2v __attribute__((ext_vector_type(2))); typedef unsigned u32x2v __attribute__((ext_vector_type(2)));
        const PG8_LAS f32x2v* S = (const PG8_LAS f32x2v*)(lds + 8192);
        const int col0 = u.pn * BM + wc * 32 + 4 * fq;
#pragma unroll
        for (int bj = 0; bj < 2; ++bj)
#pragma unroll
            for (int n = 0; n < 2; ++n) { const f32x4 bv = bias ? *(const f32x4*)(bias + col0 + bj * HALF + n * 16) : (f32x4){0.f, 0.f, 0.f, 0.f};
#pragma unroll
                for (int ai = 0; ai < 2; ++ai)
#pragma unroll
                    for (int m = 0; m < 4; ++m) acc[ai][bj][m][n] += bv; }
        bool bad = st1.run(acc, u, wr, wc, fr, fq, lds, wid, lane) || poison != 0u;
        const float qnan = __builtin_nanf("");
#pragma unroll
        for (int ai = 0; ai < 2; ++ai)
#pragma unroll
            for (int m = 0; m < 4; ++m) { const int r = ai * HALF + wr * 64 + m * 16 + fr; const f32x2v sr = S[r]; const size_t off = (size_t)(u.pm * BM + r) * ldc + col0;
#pragma unroll
                for (int bj = 0; bj < 2; ++bj)
#pragma unroll
                    for (int n = 0; n < 2; ++n) { const f32x4 bs = *(const f32x4*)(base + off + bj * HALF + n * 16); acc[ai][bj][m][n] = bs + (acc[ai][bj][m][n] - sr.x) * sr.y; }
                asm volatile("" : "+v"(acc[ai][0][m][0]), "+v"(acc[ai][0][m][1]), "+v"(acc[ai][1][m][0]), "+v"(acc[ai][1][m][1]));
                if (m & 1) asm volatile("" ::: "memory"); }
        const bool bad1 = bad;
        bad = st2.run(acc, u, wr, wc, fr, fq, lds, wid, lane) || bad;
#pragma unroll
        for (int ai = 0; ai < 2; ++ai)
#pragma unroll
            for (int m = 0; m < 4; ++m) { const int r = ai * HALF + wr * 64 + m * 16 + fr; const f32x2v sr = S[r]; const size_t off = (size_t)(u.pm * BM + r) * ldc + col0;
#pragma unroll
                for (int bj = 0; bj < 2; ++bj)
#pragma unroll
                    for (int n = 0; n < 2; ++n) { const f32x4 x1 = acc[ai][bj][m][n]; *(f32x4*)(out + off + bj * HALF + n * 16) = bad1 ? (f32x4){qnan, qnan, qnan, qnan} : x1;
                        const f32x4 o = (x1 - sr.x) * sr.y; u32x2v w; w.x = cvt_pk_bf16(o[0], o[1]); w.y = cvt_pk_bf16(o[2], o[3]);
                        if (bad) { w.x = 0x7fc07fc0u; w.y = 0x7fc07fc0u; } *(u32x2v*)(xn + off + bj * HALF + n * 16) = w; }
                asm volatile("" ::: "memory"); }
    }
};

template <class Epi, class Sched, bool ALIGN_EPI = false, bool SP2 = false>
__device__ __forceinline__ void gemm_phase(PG8_LAS unsigned char* lds, const Gemm g, const Sched& S, const Epi& E) {
    int tid_ = threadIdx.x; asm volatile("" : "+v"(tid_));
    const int tid = tid_, wid = __builtin_amdgcn_readfirstlane(tid >> 6), lane = tid & 63, wr = wid >> 2, wc = wid & 3, fr = lane & 15, fq = lane >> 4;
    const int K = g.K, nt = K / BK;
    unsigned voffA[2], voffB[2];
#pragma unroll
    for (int i = 0; i < 2; ++i) { int R, C; stage_rc(tid * 16 + i * 8192, R, C); const int Rb = Epi::PERM ? ((R & ~31) + perm32(R & 31)) : R;
        voffA[i] = (unsigned)(R * K + C) * 2u; voffB[i] = (unsigned)(Rb * K + C) * 2u; }
    const size_t kstep = (size_t)(BK * 2);
    const size_t hstep = (size_t)HALF * K * 2;
    const size_t tstep = 2 * hstep;
    const unsigned ldsw = (unsigned)wid * 1024u;
    const int aoff = lds_byte(wr * 64 + fr, fq * 8), boff = lds_byte(wc * 32 + fr, fq * 8);
#define PG8_SA(b, h) (((b) * 2 + (h)) * HTB)
#define PG8_SB(b, h) ((4 + (b) * 2 + (h)) * HTB)
#define PG8_STAGE(bufoff, gbase, voff) do { _Pragma("unroll") for (int _i = 0; _i < 2; ++_i) \
        __builtin_amdgcn_global_load_lds((const unsigned*)((const char*)(gbase) + (voff)[_i]), (PG8_LAS unsigned*)(lds + (bufoff) + ldsw + _i * 8192), 16, 0, 0); } while (0)
#define PG8_LDA(dst, b, h) do { _Pragma("unroll") for (int m = 0; m < 4; ++m) _Pragma("unroll") for (int k = 0; k < 2; ++k) dst[m][k] = *(const PG8_LAS bf16x8*)(lds + PG8_SA(b, h) + aoff + m * 2048 + k * 1024); } while (0)
#define PG8_LDB(dst, b, h) do { _Pragma("unroll") for (int n = 0; n < 2; ++n) _Pragma("unroll") for (int k = 0; k < 2; ++k) dst[n][k] = *(const PG8_LAS bf16x8*)(lds + PG8_SB(b, h) + boff + n * 2048 + k * 1024); } while (0)
#define PG8_MMA(ai, bj, At, Bt) do { __builtin_amdgcn_s_setprio(1); _Pragma("unroll") for (int m = 0; m < 4; ++m) _Pragma("unroll") for (int n = 0; n < 2; ++n) _Pragma("unroll") for (int k = 0; k < 2; ++k) \
        acc[ai][bj][m][n] = __builtin_amdgcn_mfma_f32_16x16x32_bf16(Bt[n][k], At[m][k], acc[ai][bj][m][n], 0, 0, 0); __builtin_amdgcn_s_setprio(0); } while (0)
#define PG8_WAIT_V(n) asm volatile("s_waitcnt vmcnt(" #n ")" ::: "memory")
#define PG8_WAIT_L(n) asm volatile("s_waitcnt lgkmcnt(" #n ")" ::: "memory")
#define PG8_BAR __builtin_amdgcn_s_barrier()
#define PG8_SCHED __builtin_amdgcn_sched_barrier(0)
    Unit cur, nxt; int ui = 0;
    if (!S.next(0, cur)) return;
    f32x4 acc[2][2][4][2];
#pragma unroll
    for (int a = 0; a < 2; ++a)
#pragma unroll
        for (int b = 0; b < 2; ++b)
#pragma unroll
            for (int m = 0; m < 4; ++m)
#pragma unroll
                for (int n = 0; n < 2; ++n) acc[a][b][m][n] = (f32x4){0.f, 0.f, 0.f, 0.f};
    bf16x8 At[4][2], B0[2][2], B1[2][2];
    const char* cA = (const char*)g.A + (size_t)cur.pm * tstep; const char* cB = (const char*)g.Bt + (size_t)cur.pn * tstep;
    S.a_ready(cur);
    if constexpr (SP2) {
        PG8_STAGE(PG8_SB(0, 0), cB, voffB); PG8_STAGE(PG8_SB(0, 1), cB + hstep, voffB); PG8_STAGE(PG8_SA(0, 0), cA, voffA); PG8_STAGE(PG8_SA(0, 1), cA + hstep, voffA);
        if (wr == 1) PG8_BAR;
        PG8_WAIT_V(2); PG8_BAR;
        PG8_STAGE(PG8_SB(1, 0), cB + kstep, voffB); PG8_STAGE(PG8_SA(1, 0), cA + kstep, voffA); PG8_STAGE(PG8_SB(1, 1), cB + hstep + kstep, voffB);
        PG8_WAIT_V(6); PG8_BAR;
    } else {
        PG8_STAGE(PG8_SB(0, 0), cB, voffB); PG8_STAGE(PG8_SA(0, 0), cA, voffA); PG8_STAGE(PG8_SB(0, 1), cB + hstep, voffB); PG8_STAGE(PG8_SA(0, 1), cA + hstep, voffA);
        if (wr == 1) PG8_BAR;
        PG8_WAIT_V(4); PG8_BAR;
        PG8_STAGE(PG8_SB(1, 0), cB + kstep, voffB); PG8_STAGE(PG8_SA(1, 0), cA + kstep, voffA); PG8_STAGE(PG8_SB(1, 1), cB + hstep + kstep, voffB);
        PG8_WAIT_V(6); PG8_BAR;
    }
    for (;;) {
        const bool has_next = S.next(ui + 1, nxt);
        const char* nA = has_next ? (const char*)g.A + (size_t)nxt.pm * tstep : cA; const char* nB = has_next ? (const char*)g.Bt + (size_t)nxt.pn * tstep : cB;
        for (int t = 0; t < nt; t += 2) {
            const bool last = (t == nt - 2);
            const char* a1 = cA + (size_t)(t + 1) * kstep;
            const char* a2 = last ? nA : cA + (size_t)(t + 2) * kstep; const char* b2 = last ? nB : cB + (size_t)(t + 2) * kstep;
            const char* a3 = a2 + kstep; const char* b3 = b2 + kstep;
            if (last && has_next) S.a_ready(nxt);
            if constexpr (SP2) {
            PG8_LDB(B0, 0, 0); PG8_LDB(B1, 0, 1); PG8_SCHED; PG8_LDA(At, 0, 0); PG8_STAGE(PG8_SA(1, 1), a1 + hstep, voffA);
            PG8_WAIT_V(8); PG8_WAIT_L(0); PG8_BAR; PG8_MMA(0, 0, At, B0); PG8_MMA(0, 1, At, B1); PG8_BAR; PG8_SCHED;
            PG8_LDA(At, 0, 1); PG8_STAGE(PG8_SB(0, 0), b2, voffB); PG8_STAGE(PG8_SB(0, 1), b2 + hstep, voffB); PG8_STAGE(PG8_SA(0, 0), a2, voffA);
            PG8_WAIT_V(8); PG8_WAIT_L(0); PG8_BAR; PG8_MMA(1, 0, At, B0); PG8_MMA(1, 1, At, B1); PG8_BAR; PG8_SCHED;
            PG8_LDB(B0, 1, 0); PG8_LDB(B1, 1, 1); PG8_SCHED; PG8_LDA(At, 1, 0); PG8_STAGE(PG8_SA(0, 1), a2 + hstep, voffA);
            PG8_WAIT_V(8); PG8_WAIT_L(0); PG8_BAR; PG8_MMA(0, 0, At, B0); PG8_MMA(0, 1, At, B1); PG8_BAR; PG8_SCHED;
            PG8_LDA(At, 1, 1); PG8_STAGE(PG8_SB(1, 0), b3, voffB); PG8_STAGE(PG8_SB(1, 1), b3 + hstep, voffB); PG8_STAGE(PG8_SA(1, 0), a3, voffA);
            PG8_WAIT_V(8); PG8_WAIT_L(0); PG8_BAR; PG8_MMA(1, 0, At, B0); PG8_MMA(1, 1, At, B1); PG8_BAR; PG8_SCHED;
            } else {
            PG8_LDB(B0, 0, 0); PG8_SCHED; PG8_LDA(At, 0, 0); PG8_STAGE(PG8_SA(1, 1), a1 + hstep, voffA);
            PG8_WAIT_L(8); PG8_BAR; PG8_WAIT_L(0); PG8_MMA(0, 0, At, B0); PG8_BAR; PG8_SCHED;
            PG8_LDB(B1, 0, 1); PG8_STAGE(PG8_SB(0, 0), b2, voffB);
            PG8_BAR; PG8_WAIT_L(0); PG8_MMA(0, 1, At, B1); PG8_BAR;
            PG8_LDA(At, 0, 1); PG8_STAGE(PG8_SA(0, 0), a2, voffA);
            PG8_BAR; PG8_WAIT_L(0); PG8_MMA(1, 0, At, B0); PG8_BAR; PG8_SCHED;
            PG8_STAGE(PG8_SB(0, 1), b2 + hstep, voffB);
            PG8_WAIT_V(6); PG8_BAR; PG8_MMA(1, 1, At, B1); PG8_BAR;
            PG8_LDB(B0, 1, 0); PG8_SCHED; PG8_LDA(At, 1, 0); PG8_STAGE(PG8_SA(0, 1), a2 + hstep, voffA);
            PG8_WAIT_L(8); PG8_BAR; PG8_WAIT_L(0); PG8_MMA(0, 0, At, B0); PG8_BAR; PG8_SCHED;
            PG8_LDB(B1, 1, 1); PG8_STAGE(PG8_SB(1, 0), b3, voffB);
            PG8_BAR; PG8_WAIT_L(0); PG8_MMA(0, 1, At, B1); PG8_BAR;
            PG8_LDA(At, 1, 1); PG8_STAGE(PG8_SA(1, 0), a3, voffA);
            PG8_BAR; PG8_WAIT_L(0); PG8_MMA(1, 0, At, B0); PG8_BAR; PG8_SCHED;
            PG8_STAGE(PG8_SB(1, 1), b3 + hstep, voffB);
            PG8_WAIT_V(6); PG8_BAR; PG8_MMA(1, 1, At, B1); PG8_BAR;
            }
        }
        if constexpr (ALIGN_EPI) { if (wr == 0) PG8_BAR; }
        if constexpr (!Epi::AFTER_DRAIN) { E(acc, cur, wr, wc, fr, fq); S.done(cur); }
        if (!has_next) break;
#pragma unroll
        for (int a = 0; a < 2; ++a)
#pragma unroll
            for (int b = 0; b < 2; ++b)
#pragma unroll
                for (int m = 0; m < 4; ++m)
#pragma unroll
                    for (int n = 0; n < 2; ++n) acc[a][b][m][n] = (f32x4){0.f, 0.f, 0.f, 0.f};
        cur = nxt; cA = nA; cB = nB; ++ui;
        if constexpr (ALIGN_EPI) { if (wr == 1) PG8_BAR; }
    }
    PG8_WAIT_V(0);
    if constexpr (!ALIGN_EPI) { if (wr == 0) PG8_BAR; }
    PG8_BAR;
    if constexpr (Epi::AFTER_DRAIN) { E.fused(acc, cur, wr, wc, fr, fq, lds, wid, lane); S.done(cur); }
#undef PG8_SA
#undef PG8_SB
#undef PG8_STAGE
#undef PG8_LDA
#undef PG8_LDB
#undef PG8_MMA
#undef PG8_WAIT_V
#undef PG8_WAIT_L
#undef PG8_BAR
#undef PG8_SCHED
}
}
namespace pg8 {
typedef float f32x2c __attribute__((ext_vector_type(2))); typedef __bf16 bf16x2c __attribute__((ext_vector_type(2)));
__device__ __forceinline__ unsigned cvt2(float lo, float hi) { f32x2c v = {lo, hi}; bf16x2c b = __builtin_convertvector(v, bf16x2c); return __builtin_bit_cast(unsigned, b); }
struct EpiStore {
    static constexpr bool PERM = true, AFTER_DRAIN = false;
    bf16_t* O; int ldc; int split_cols; size_t split_stride; int act; int act_from; int tr_tile;
    __device__ __forceinline__ void operator()(const f32x4 (&acc)[2][2][4][2], const Unit& u, int wr, int wc, int fr, int fq) const {
        const int row0 = u.pm * BM + wr * 64 + fr; int colt = u.pn * BM; bf16_t* base = O; int a = act;
        bool tr = false;
        if (split_cols) { const int t = colt / split_cols; base += (size_t)t * split_stride; colt -= t * split_cols; if (act == 1 && t < act_from) a = 0; tr = (t == tr_tile); }
        const int col0 = colt + wc * 32 + 8 * fq;
        if (tr) {
#pragma unroll
            for (int ai = 0; ai < 2; ++ai)
#pragma unroll
                for (int m = 0; m < 4; ++m) { const int row = row0 + ai * HALF + m * 16; bf16_t* cp = base + ((size_t)(row >> 13) * 1024 + col0) * 8192 + (row & 8191);
#pragma unroll
                    for (int bj = 0; bj < 2; ++bj)
#pragma unroll
                        for (int n = 0; n < 2; ++n)
#pragma unroll
                            for (int e = 0; e < 4; ++e) cp[(size_t)(bj * HALF + 4 * n + e) * 8192] = (bf16_t)(cvt2(acc[ai][bj][m][n][e], 0.f) & 0xffffu); }
            return;
        }
#pragma unroll
        for (int ai = 0; ai < 2; ++ai)
#pragma unroll
            for (int m = 0; m < 4; ++m) { bf16_t* rowp = base + (size_t)(row0 + ai * HALF + m * 16) * ldc + col0;
#pragma unroll
                for (int bj = 0; bj < 2; ++bj) { f32x4 v0 = acc[ai][bj][m][0], v1 = acc[ai][bj][m][1];
                    if (a == 1) {
#pragma unroll
                        for (int e = 0; e < 4; ++e) { v0[e] = __builtin_amdgcn_rcpf(1.0f + __expf(-v0[e])); v1[e] = __builtin_amdgcn_rcpf(1.0f + __expf(-v1[e])); }
                    } else if (a == 2) {
#pragma unroll
                        for (int e = 0; e < 4; ++e) { float p = fmaxf(v0[e], 0.f), q = fmaxf(v1[e], 0.f); v0[e] = p * p; v1[e] = q * q; }
                    }
                    u32x4 w; w.x = cvt2(v0[0], v0[1]); w.y = cvt2(v0[2], v0[3]); w.z = cvt2(v1[0], v1[1]); w.w = cvt2(v1[2], v1[3]);
                    *(u32x4*)(rowp + bj * HALF) = w; } }
    }
};
struct GateSched {
    StaticOrder base;
    __device__ __forceinline__ bool next(int i, Unit& u) const { Unit ub; if (!base.next(i / 3, ub)) return false; const int br = i % 3; u.pm = ub.pm + 64 * br; u.pn = ub.pn + 4 * br; return true; }
    __device__ __forceinline__ void a_ready(const Unit&) const {}
    __device__ __forceinline__ void done(const Unit&) const {}
};
struct EpiGate {
    static constexpr bool PERM = true, AFTER_DRAIN = false;
    const bf16_t* G; float* MG; bf16_t* MGb; size_t gstride;
    __device__ __forceinline__ void operator()(const f32x4 (&acc)[2][2][4][2], const Unit& u, int wr, int wc, int fr, int fq) const {
        const int mode = u.pm >> 6, pm = u.pm & 63, pn = u.pn & 3; const bf16_t* Gb = G + (size_t)mode * gstride;
        const int row0 = pm * BM + wr * 64 + fr; const int col0 = pn * BM + wc * 32 + 8 * fq;
#pragma unroll
        for (int ai = 0; ai < 2; ++ai)
#pragma unroll
            for (int m = 0; m < 4; ++m) { const size_t off = (size_t)(row0 + ai * HALF + m * 16) * 1024 + col0;
#pragma unroll
                for (int bj = 0; bj < 2; ++bj) { const size_t o2 = off + bj * HALF;
                    const u32x4 gw = *(const u32x4*)(Gb + o2);
                    f32x4 g0, g1;
                    g0[0] = __uint_as_float(gw.x << 16); g0[1] = __uint_as_float(gw.x & 0xffff0000u); g0[2] = __uint_as_float(gw.y << 16); g0[3] = __uint_as_float(gw.y & 0xffff0000u);
                    g1[0] = __uint_as_float(gw.z << 16); g1[1] = __uint_as_float(gw.z & 0xffff0000u); g1[2] = __uint_as_float(gw.w << 16); g1[3] = __uint_as_float(gw.w & 0xffff0000u);
                    f32x4 v0 = acc[ai][bj][m][0] * g0, v1 = acc[ai][bj][m][1] * g1;
                    if (mode != 0) { const u32x4 pw = *(const u32x4*)(MGb + o2);
                        v0[0] += __uint_as_float(pw.x << 16); v0[1] += __uint_as_float(pw.x & 0xffff0000u); v0[2] += __uint_as_float(pw.y << 16); v0[3] += __uint_as_float(pw.y & 0xffff0000u);
                        v1[0] += __uint_as_float(pw.z << 16); v1[1] += __uint_as_float(pw.z & 0xffff0000u); v1[2] += __uint_as_float(pw.w << 16); v1[3] += __uint_as_float(pw.w & 0xffff0000u); }
                    u32x4 w; w.x = cvt2(v0[0], v0[1]); w.y = cvt2(v0[2], v0[3]); w.z = cvt2(v1[0], v1[1]); w.w = cvt2(v1[2], v1[3]); *(u32x4*)(MGb + o2) = w; } }
    }
};
struct EpiRes {
    static constexpr bool PERM = false, AFTER_DRAIN = false;
    const float* base; float* out;
    __device__ __forceinline__ void operator()(const f32x4 (&acc)[2][2][4][2], const Unit& u, int wr, int wc, int fr, int fq) const {
        const int col0 = u.pn * BM + wc * 32 + 4 * fq;
#pragma unroll
        for (int ai = 0; ai < 2; ++ai)
#pragma unroll
            for (int m = 0; m < 4; ++m) { const size_t off = (size_t)(u.pm * BM + ai * HALF + wr * 64 + m * 16 + fr) * 1024 + col0;
#pragma unroll
                for (int bj = 0; bj < 2; ++bj)
#pragma unroll
                    for (int n = 0; n < 2; ++n) { const f32x4 bs = *(const f32x4*)(base + off + bj * HALF + n * 16); *(f32x4*)(out + off + bj * HALF + n * 16) = bs + acc[ai][bj][m][n]; } }
    }
};
}
constexpr int BATCH = 2, SEQ = 8192, DM = 1024, M = BATCH * SEQ, NIN = 13320, FF = 4096;
constexpr float EPS = 1e-6f;
constexpr float SB_THR = -30.0f;
constexpr size_t MiB = 1u << 20;
constexpr size_t WS_GATES = 1 * MiB;
constexpr size_t WS_MLOC = 1 * MiB + 512 * 1024, WS_BLAST = WS_MLOC + 4096, WS_MST = WS_BLAST + 4096;
constexpr size_t WS_WIN = 2 * MiB, WS_WML = 28 * MiB, WS_WSC = 30 * MiB, WS_WSB = 32 * MiB, WS_WOUT = 34 * MiB, WS_WUP = 36 * MiB, WS_WDN = 44 * MiB;
constexpr size_t WS_XN = 52 * MiB, WS_YML = 84 * MiB, WS_BIG = 116 * MiB;
constexpr size_t WS_PA = WS_BIG;
constexpr size_t WS_ST = 244 * MiB, WS_DN = 372 * MiB;
constexpr size_t WS_P2 = WS_BIG;
constexpr size_t WS_YSC = WS_XN, WS_YSB = WS_P2;
constexpr size_t WS_MG = WS_BIG + 32 * MiB, WS_MGB = WS_BIG + 96 * MiB, WS_HB = WS_BIG + 128 * MiB;
constexpr size_t WS_END = 404 * MiB;
constexpr int LDS_BYTES = 147456;
constexpr int NPH = 12;

#ifndef DRYLVL
#define DRYLVL 0
#endif
#ifndef DUP_MASK
#define DUP_MASK 0
#endif
#ifndef PHMASK
#define PHMASK 0x1fff
#endif
#define LAS __attribute__((address_space(3)))
typedef unsigned short bf16;
typedef unsigned v4u __attribute__((ext_vector_type(4)));
typedef unsigned v2u __attribute__((ext_vector_type(2)));
typedef float f32x4 __attribute__((ext_vector_type(4)));
typedef short bf16x8 __attribute__((ext_vector_type(8)));
__device__ __forceinline__ float bflo(unsigned w) { return __uint_as_float(w << 16); }
__device__ __forceinline__ float bfhi(unsigned w) { return __uint_as_float(w & 0xffff0000u); }
__device__ __forceinline__ float bf2f(unsigned short h) { return __uint_as_float((unsigned)h << 16); }
typedef float f32x2_t __attribute__((ext_vector_type(2))); typedef __bf16 bf16x2_t __attribute__((ext_vector_type(2)));
__device__ __forceinline__ unsigned pk2(float lo, float hi) { f32x2_t v = {lo, hi}; bf16x2_t b = __builtin_convertvector(v, bf16x2_t); return __builtin_bit_cast(unsigned, b); }
__device__ __forceinline__ unsigned short f2bf(float f) { return (unsigned short)(pk2(f, 0.f) & 0xffffu); }
__device__ __forceinline__ float wave_sum(float v) {
#pragma unroll
    for (int o = 1; o < 64; o <<= 1) v += __shfl_xor(v, o);
    return v;
}
__device__ __forceinline__ float wave_max(float v) {
#pragma unroll
    for (int o = 1; o < 64; o <<= 1) v = fmaxf(v, __shfl_xor(v, o));
    return v;
}
__device__ __forceinline__ float wave_prefix(float v, int lane) {
#pragma unroll
    for (int o = 1; o < 64; o <<= 1) { const float n = __shfl_up(v, o); if (lane >= o) v += n; }
    return v;
}
__device__ __forceinline__ float log_sigmoid(float x) { return fminf(x, 0.f) - __logf(1.0f + __expf(-fabsf(x))); }

#define XB_TMO      128
#define XB_XCNT(j)  (256  + 64 * (j))
#define XB_XSUB(j)  (1280 + 64 * (j))
#define XB_XGEN(j)  (2304 + 64 * (j))
#define XB_TOP      3328
#define XB_TOPGEN   3392
#define XCD_BAR_WORDS 3456
#define XB_SPIN_CAP (1u << 18)

__device__ __forceinline__ unsigned xb_ld(unsigned* p)              { return __hip_atomic_load(p, __ATOMIC_RELAXED, __HIP_MEMORY_SCOPE_AGENT); }
__device__ __forceinline__ unsigned xb_add(unsigned* p, unsigned v) { return __hip_atomic_fetch_add(p, v, __ATOMIC_RELAXED, __HIP_MEMORY_SCOPE_AGENT); }
__device__ __forceinline__ unsigned xb_xcc_id() { return (unsigned)__builtin_amdgcn_s_getreg((3 << 11) | 20) & 0xFu; }
#define XB_SPIN(cond, bar) do { unsigned _sp = 0; while (cond) { __builtin_amdgcn_s_sleep(1); \
    if ((++_sp & 255u) == 0u) { if (xb_ld(&(bar)[XB_TMO])) break; if (_sp > XB_SPIN_CAP) { atomicAdd(&(bar)[XB_TMO], 1u); break; } } } } while (0)

struct XcdBarrier {
    unsigned* bar; unsigned x;
    volatile LAS unsigned* st;
};

__device__ __forceinline__ XcdBarrier xcd_barrier_post(unsigned* bar, volatile LAS unsigned* st) {
    XcdBarrier b; b.bar = bar; b.x = xb_xcc_id(); b.st = st;
    if (threadIdx.x == 0) (void)xb_add(&bar[XB_XCNT(b.x)], 1u);
    return b;
}
__device__ __forceinline__ void xcd_barrier_complete(unsigned* bar, unsigned x, unsigned& nloc, unsigned& nx) {
    const unsigned G = gridDim.x * gridDim.y * gridDim.z;
    unsigned sum, cnt, mine, sp = 0u;
    for (;;) {
        sum = 0u; cnt = 0u; mine = 0u;
#pragma unroll
        for (unsigned j = 0; j < 16; ++j) { const unsigned c = xb_ld(&bar[XB_XCNT(j)]); sum += c; cnt += (c > 0u) ? 1u : 0u; mine = (j == x) ? c : mine; }
        if (sum == G) break;
        __builtin_amdgcn_s_sleep(1);
        if ((++sp & 255u) == 0u) { if (xb_ld(&bar[XB_TMO])) break; if (sp > XB_SPIN_CAP) { atomicAdd(&bar[XB_TMO], 1u); break; } }
    }
    nloc = mine > 0u ? mine : 1u; nx = cnt > 0u ? cnt : 1u;
}

__device__ __forceinline__ void xcd_barrier(const XcdBarrier& b) {
    asm volatile("s_waitcnt vmcnt(0)" ::: "memory");
    __syncthreads();
    if (threadIdx.x == 0) {
        unsigned* bar = b.bar;
        __builtin_amdgcn_s_waitcnt(0);
        unsigned nloc = b.st[0], nx = b.st[1];
        if (nloc == 0u) { xcd_barrier_complete(bar, b.x, nloc, nx); b.st[0] = nloc; b.st[1] = nx; }
        const unsigned old = xb_add(&bar[XB_XSUB(b.x)], 1u);
        const unsigned gen = old / nloc;
        if (old + 1u == (gen + 1u) * nloc) {
            __builtin_amdgcn_fence(__ATOMIC_RELEASE, "agent");
            asm volatile("s_waitcnt vmcnt(0)" ::: "memory");
            const unsigned og = xb_add(&bar[XB_TOP], 1u);
            const unsigned tg = og / nx;
            if (og + 1u == (tg + 1u) * nx) xb_add(&bar[XB_TOPGEN], 1u);
            else XB_SPIN(xb_ld(&bar[XB_TOPGEN]) == tg, bar);
            __builtin_amdgcn_fence(__ATOMIC_ACQUIRE, "agent");
            xb_add(&bar[XB_XGEN(b.x)], 1u);
            asm volatile("s_waitcnt vmcnt(0)" ::: "memory");
        } else {
            XB_SPIN(xb_ld(&bar[XB_XGEN(b.x)]) == gen, bar);
            __builtin_amdgcn_fence(__ATOMIC_ACQUIRE, "agent");
            asm volatile("s_waitcnt vmcnt(0)" ::: "memory");
        }
    }
    __syncthreads();
}

constexpr int MISC_OFF = 131072 + 320;
struct Args { const float* in[14]; float* out; unsigned char* ws; int ph_lo, ph_hi; };

__device__ __forceinline__ void transpose_item(const float* W, int pitch, int ncols, int K, bf16* WT, int row_off, LAS float* scr, int item, int lane) {
    const int nblk = ncols / 32, kb = item / nblk, nb = item % nblk, k0 = 64 * kb, n0 = 32 * nb;
    f32x4 wv[8];
#pragma unroll
    for (int i = 0; i < 8; ++i) wv[i] = *(const f32x4*)(W + (size_t)(k0 + 8 * i + (lane >> 3)) * pitch + n0 + 4 * (lane & 7));
#pragma unroll
    for (int i = 0; i < 8; ++i) { LAS float* d = scr + (8 * i + (lane >> 3)) * 33 + 4 * (lane & 7); d[0] = wv[i].x; d[1] = wv[i].y; d[2] = wv[i].z; d[3] = wv[i].w; }
    asm volatile("s_waitcnt lgkmcnt(0)" ::: "memory");
    const int c = lane & 7;
#pragma unroll
    for (int j = 0; j < 4; ++j) { const int n = (lane >> 3) + 8 * j; const LAS float* s = scr + (8 * c) * 33 + n;
        v4u o; o.x = pk2(s[0 * 33], s[1 * 33]); o.y = pk2(s[2 * 33], s[3 * 33]); o.z = pk2(s[4 * 33], s[5 * 33]); o.w = pk2(s[6 * 33], s[7 * 33]);
        *(v4u*)(WT + (size_t)(row_off + n0 + n) * K + k0 + 8 * c) = o; }
    asm volatile("s_waitcnt lgkmcnt(0)" ::: "memory");
}

template <int MODE>
__device__ __forceinline__ void norm_row(const float* xrow, const float* gain, bf16* orow, float* frow, const LAS float* Wg, const float* bias, float* grow, int lane) {
    const f32x4* xr = (const f32x4*)xrow + lane; const f32x4* gr = (const f32x4*)gain + lane;
    f32x4 v[4]; float s = 0.f;
#pragma unroll
    for (int j = 0; j < 4; ++j) { v[j] = xr[64 * j]; s += (v[j].x * v[j].x + v[j].y * v[j].y) + (v[j].z * v[j].z + v[j].w * v[j].w); }
    const float rstd = __builtin_amdgcn_rsqf(wave_sum(s) * (1.0f / DM) + EPS);
#pragma unroll
    for (int j = 0; j < 4; ++j) v[j] = v[j] * rstd * gr[64 * j];
    if (MODE == 2) {
#pragma unroll
        for (int j = 0; j < 4; ++j) ((f32x4*)frow)[lane + 64 * j] = v[j];
    } else {
#pragma unroll
        for (int j = 0; j < 4; ++j) { v2u o; o.x = pk2(v[j].x, v[j].y); o.y = pk2(v[j].z, v[j].w); ((v2u*)orow)[lane + 64 * j] = o; }
    }
    if (MODE == 1) {
        float ga[8];
#pragma unroll
        for (int i = 0; i < 8; ++i) ga[i] = 0.f;
#pragma unroll
        for (int j = 0; j < 4; ++j)
#pragma unroll
            for (int e = 0; e < 4; ++e) { const int k = 4 * lane + 256 * j + e; const f32x4 a = *(const LAS f32x4*)(Wg + k * 8), b = *(const LAS f32x4*)(Wg + k * 8 + 4); const float x = v[j][e];
                ga[0] += x * a.x; ga[1] += x * a.y; ga[2] += x * a.z; ga[3] += x * a.w; ga[4] += x * b.x; ga[5] += x * b.y; ga[6] += x * b.z; ga[7] += x * b.w; }
#pragma unroll
        for (int i = 0; i < 8; ++i) ga[i] = wave_sum(ga[i]);
        if (lane == 0) {
            f32x4 o0 = {ga[0] + bias[0], ga[1] + bias[1], ga[2] + bias[2], ga[3] + bias[3]}, o1 = {ga[4] + bias[4], ga[5] + bias[5], ga[6] + bias[6], ga[7] + bias[7]};
            ((f32x4*)grow)[0] = o0; ((f32x4*)grow)[1] = o1; }
    }
}

template <int MODE>
__device__ __forceinline__ void norm_row_pair(const float* x0, const float* x1, const float* gain, bf16* o0, bf16* o1, float* f0, float* f1, int lane) {
    const f32x4* xa = (const f32x4*)x0 + lane; const f32x4* xb = (const f32x4*)x1 + lane; const f32x4* gr = (const f32x4*)gain + lane;
    f32x4 v[4], w[4], g[4]; float sa = 0.f, sb = 0.f;
#pragma unroll
    for (int j = 0; j < 4; ++j) { v[j] = xa[64 * j]; w[j] = xb[64 * j]; g[j] = gr[64 * j]; }
#pragma unroll
    for (int j = 0; j < 4; ++j) { sa += (v[j].x * v[j].x + v[j].y * v[j].y) + (v[j].z * v[j].z + v[j].w * v[j].w); sb += (w[j].x * w[j].x + w[j].y * w[j].y) + (w[j].z * w[j].z + w[j].w * w[j].w); }
    const float ra = __builtin_amdgcn_rsqf(wave_sum(sa) * (1.0f / DM) + EPS), rb = __builtin_amdgcn_rsqf(wave_sum(sb) * (1.0f / DM) + EPS);
#pragma unroll
    for (int j = 0; j < 4; ++j) { v[j] = v[j] * ra * g[j]; w[j] = w[j] * rb * g[j]; }
    if (MODE == 2) {
#pragma unroll
        for (int j = 0; j < 4; ++j) { ((f32x4*)f0)[lane + 64 * j] = v[j]; ((f32x4*)f1)[lane + 64 * j] = w[j]; }
    } else {
#pragma unroll
        for (int j = 0; j < 4; ++j) { v2u a; a.x = pk2(v[j].x, v[j].y); a.y = pk2(v[j].z, v[j].w); ((v2u*)o0)[lane + 64 * j] = a; v2u b; b.x = pk2(w[j].x, w[j].y); b.y = pk2(w[j].z, w[j].w); ((v2u*)o1)[lane + 64 * j] = b; }
    }
}

__global__ void __launch_bounds__(512, 2) mega(Args args) {
    extern __shared__ __attribute__((aligned(16))) unsigned char lds[];
    cg::grid_group grid = cg::this_grid();
    typedef const Args __attribute__((address_space(4))) CArgs;
#define PH_INIT \
    CArgs* ap = (CArgs*)__builtin_amdgcn_kernarg_segment_ptr(); asm volatile("" : "+s"(ap)); \
    int tid = threadIdx.x; asm volatile("" : "+v"(tid)); \
    LAS unsigned char* L = (LAS unsigned char*)lds; \
    const int lane = tid & 63, wave = __builtin_amdgcn_readfirstlane(tid >> 6); \
    const int G = gridDim.x; const int bx = blockIdx.x; const int vcu = (G % 8 == 0) ? (bx % 8) * (G / 8) + bx / 8 : bx; \
    const int lr = lane & 15, lg = lane >> 4; \
    unsigned char* ws = ap->ws; float* out = ap->out; \
    float* GATES = (float*)(ws + WS_GATES); float* MLOC = (float*)(ws + WS_MLOC); float* BLAST = (float*)(ws + WS_BLAST); float* MST = (float*)(ws + WS_MST); \
    bf16* XN = (bf16*)(ws + WS_XN); bf16* YML = (bf16*)(ws + WS_YML); \
    bf16* ST = (bf16*)(ws + WS_ST); float* DN = (float*)(ws + WS_DN); \
    const size_t TS = (size_t)M * 1024; \
    bf16* PA = (bf16*)(ws + WS_PA); bf16* P2 = (bf16*)(ws + WS_P2); \
    (void)lane; (void)wave; (void)vcu; (void)lr; (void)lg; (void)out; (void)GATES; (void)MLOC; (void)BLAST; (void)MST; (void)XN; (void)YML; (void)ST; (void)DN; (void)TS; (void)PA; (void)P2; (void)L; (void)bx;
    { int t0 = threadIdx.x; if (t0 < 32) ((LAS unsigned*)((LAS unsigned char*)lds + MISC_OFF))[t0] = 0u; }
    __syncthreads();
    { CArgs* apb = (CArgs*)__builtin_amdgcn_kernarg_segment_ptr(); (void)xcd_barrier_post((unsigned*)apb->ws, (volatile LAS unsigned*)((LAS unsigned char*)lds + MISC_OFF) + 8); }
    int ph_lo, ph_hi;
    { CArgs* ap0 = (CArgs*)__builtin_amdgcn_kernarg_segment_ptr(); ph_lo = ap0->ph_lo; ph_hi = ap0->ph_hi; }

    for (int p = ph_lo; p < ph_hi; ++p) {
        if (p > ph_lo) {
            if (ph_hi < 0) grid.sync();
            { CArgs* apb = (CArgs*)__builtin_amdgcn_kernarg_segment_ptr(); XcdBarrier xbr; xbr.bar = (unsigned*)apb->ws; xbr.x = xb_xcc_id(); xbr.st = (volatile LAS unsigned*)((LAS unsigned char*)lds + MISC_OFF) + 8; xcd_barrier(xbr); }
        }
        const int l = p / NPH, k = (p == 2 * NPH) ? NPH : p % NPH;
        const int nrep = ((DUP_MASK >> k) & 1) ? 2 : 1;
        for (int rep = 0; rep < nrep; ++rep) { const bool dry = rep + 1 < nrep; (void)dry;
        switch (k) {
        case 0: { if (!((PHMASK >> 0) & 1)) break; PH_INIT
            LAS float* scr = (LAS float*)(L + wave * 8704);
            const int gw = vcu * 8 + wave, NGW = G * 8;
            const float* win = ap->in[2] + (size_t)l * 1024 * NIN;
            for (int it = gw; it < 12800; it += NGW) {
                if (it < 6656) { const int grp = it >> 9, r = it & 511;
                    const int coff = grp < 4 ? grp * 1024 : (grp == 4 ? 7176 : (grp < 8 ? 4104 + (grp - 5) * 1024 : (grp < 10 ? 8200 + (grp - 8) * 1024 : (grp == 10 ? 11272 : (grp == 11 ? 10248 : 12296)))));
                    transpose_item(win + coff, NIN, 1024, 1024, (bf16*)(ws + WS_WIN), grp * 1024, scr, r, lane); }
                else if (it < 8704) { const int mi = (it - 6656) >> 9, r = (it - 6656) & 511;
                    transpose_item(ap->in[mi == 0 ? 7 : (mi == 1 ? 6 : 6 + mi)] + (size_t)l * 1024 * 1024, 1024, 1024, 1024, (bf16*)(ws + WS_WML + (size_t)mi * 2 * MiB), 0, scr, r, lane); }
                else if (it < 10752) transpose_item(ap->in[11] + (size_t)l * 1024 * FF, FF, FF, 1024, (bf16*)(ws + WS_WUP), 0, scr, it - 8704, lane);
                else transpose_item(ap->in[12] + (size_t)l * FF * 1024, 1024, 1024, FF, (bf16*)(ws + WS_WDN), 0, scr, it - 10752, lane);
            }
            LAS float* Wg = (LAS float*)(L + 73728);
            for (int i = tid; i < 8192; i += 512) Wg[i] = win[(size_t)(i >> 3) * NIN + 4096 + (i & 7)];
            __syncthreads();
            const float* xsrc = l == 0 ? ap->in[0] : out;
            for (int m = gw; m < M; m += NGW)
                norm_row<1>(xsrc + (size_t)m * DM, ap->in[1] + l * DM, XN + (size_t)m * DM, nullptr, Wg, ap->in[3] + l * 8, GATES + (size_t)m * 8, lane);
            __syncthreads();
        } break;
        case 1: case 5: case 10: {
            if (!((PHMASK >> k) & 1)) break; PH_INIT
            const bf16* Bt = k == 1 ? (const bf16*)(ws + WS_WIN) : (k == 5 ? (const bf16*)(ws + WS_WIN) + (size_t)4096 * 1024 : (const bf16*)(ws + WS_WUP));
            const int N = k == 1 ? 4096 : (k == 5 ? 9216 : FF);
            pg8::Gemm g{XN, Bt, M, N, 1024}; pg8::StaticOrder S; S.init(M, N, G, bx);
            pg8::EpiStore E{k == 10 ? (bf16*)(ws + WS_HB) : PA, k == 10 ? FF : 1024, k == 10 ? 0 : 1024, TS, k == 1 ? 0 : (k == 5 ? 1 : 2), 6, k == 5 ? 5 : -1};
            pg8::gemm_phase<pg8::EpiStore, pg8::StaticOrder, true, true>((PG8_LAS unsigned char*)L, g, S, E);
        } break;
        case 8: {
            if (!((PHMASK >> k) & 1)) break; PH_INIT
            pg8::Gemm g{(const bf16*)(ws + WS_MGB), (const bf16*)(ws + WS_WOUT), M, 1024, 1024}; pg8::StaticOrder S; S.init(M, 1024, G, bx);
            pg8::EpiRes E{l == 0 ? ap->in[0] : out, out};
            pg8::gemm_phase<pg8::EpiRes, pg8::StaticOrder, true, true>((PG8_LAS unsigned char*)L, g, S, E);
        } break;
        case 11: {
            if (!((PHMASK >> k) & 1)) break; PH_INIT
            pg8::Gemm g{(const bf16*)(ws + WS_HB), (const bf16*)(ws + WS_WDN), M, 1024, FF}; pg8::StaticOrder S; S.init(M, 1024, G, bx);
            pg8::EpiRes E{out, out};
            pg8::gemm_phase<pg8::EpiRes, pg8::StaticOrder, true, true>((PG8_LAS unsigned char*)L, g, S, E);
        } break;
        case 2: { if (!((PHMASK >> 2) & 1)) break; PH_INIT
            LAS bf16* KT = (LAS bf16*)L; LAS bf16* VT = (LAS bf16*)(L + 36864); LAS float* wS = (LAS float*)(L + 73728);
            for (int u = vcu; u < 1024; u += G) {
                const int bh = u >> 7, c = u & 127, b = bh >> 2, h = bh & 3; const size_t r0 = (size_t)b * SEQ + c * 64;
                v4u kq[2][2], vq[2][2];
#pragma unroll
                for (int i = 0; i < 2; ++i) { const int it = tid + 512 * i, d8 = it >> 5, sp = it & 31; const size_t go = (r0 + 2 * sp) * 1024 + h * 256 + d8 * 8;
                    kq[i][0] = *(const v4u*)(PA + TS + go); kq[i][1] = *(const v4u*)(PA + TS + go + 1024); vq[i][0] = *(const v4u*)(PA + 2 * TS + go); vq[i][1] = *(const v4u*)(PA + 2 * TS + go + 1024); }
                {
                    const float ip = GATES[(r0 + lane) * 8 + h], fp = GATES[(r0 + lane) * 8 + 4 + h];
                    const float bc = wave_prefix(log_sigmoid(fp), lane); const float blast = __shfl(bc, 63);
                    const float gg = blast - bc + ip; const float mloc = wave_max(gg);
                    wS[lane] = __expf(gg - mloc);
                    if (wave == 0 && lane == 0) { MLOC[u] = mloc; BLAST[u] = blast; }
                }
                __syncthreads();
#pragma unroll
                for (int i = 0; i < 2; ++i) { const int it = tid + 512 * i, d8 = it >> 5, sp = it & 31; const float w0 = wS[2 * sp], w1 = wS[2 * sp + 1];
                    LAS unsigned* kt = (LAS unsigned*)(KT + (d8 * 8) * 72 + 2 * sp); LAS unsigned* vt = (LAS unsigned*)(VT + (d8 * 8) * 72 + 2 * sp);
#define KV4(F, J) kt[(J) * 36] = pk2(bflo(kq[i][0].F) * 0.0625f, bflo(kq[i][1].F) * 0.0625f); kt[(J + 1) * 36] = pk2(bfhi(kq[i][0].F) * 0.0625f, bfhi(kq[i][1].F) * 0.0625f); \
                    vt[(J) * 36] = pk2(bflo(vq[i][0].F) * w0, bflo(vq[i][1].F) * w1); vt[(J + 1) * 36] = pk2(bfhi(vq[i][0].F) * w0, bfhi(vq[i][1].F) * w1);
                    KV4(x, 0) KV4(y, 2) KV4(z, 4) KV4(w, 6)
#undef KV4
                }
                __syncthreads();
                if (tid < 256) { float a = 0.f;
#pragma unroll 8
                    for (int s = 0; s < 64; ++s) a += wS[s] * bf2f(KT[tid * 72 + s]);
                    DN[(size_t)u * 256 + tid] = a; }
                bf16* Cg = ST + (size_t)u * 65536;
                {
                    const int krow = wave * 32 + 8 * (lr >> 2) + (lr & 3);
                    const bf16x8 a00 = *(const LAS bf16x8*)(KT + krow * 72 + 8 * lg), a01 = *(const LAS bf16x8*)(KT + krow * 72 + 32 + 8 * lg);
                    const bf16x8 a10 = *(const LAS bf16x8*)(KT + (krow + 4) * 72 + 8 * lg), a11 = *(const LAS bf16x8*)(KT + (krow + 4) * 72 + 32 + 8 * lg);
#pragma unroll 4
                    for (int nb = 0; nb < 16; ++nb) {
                        const bf16x8 b0 = *(const LAS bf16x8*)(VT + (nb * 16 + lr) * 72 + 8 * lg), b1 = *(const LAS bf16x8*)(VT + (nb * 16 + lr) * 72 + 32 + 8 * lg);
                        f32x4 c0 = {0.f, 0.f, 0.f, 0.f}, c1 = {0.f, 0.f, 0.f, 0.f};
                        c0 = __builtin_amdgcn_mfma_f32_16x16x32_bf16(a00, b0, c0, 0, 0, 0); c1 = __builtin_amdgcn_mfma_f32_16x16x32_bf16(a10, b0, c1, 0, 0, 0);
                        c0 = __builtin_amdgcn_mfma_f32_16x16x32_bf16(a01, b1, c0, 0, 0, 0); c1 = __builtin_amdgcn_mfma_f32_16x16x32_bf16(a11, b1, c1, 0, 0, 0);
                        v4u o; o.x = pk2(c0[0], c0[1]); o.y = pk2(c0[2], c0[3]); o.z = pk2(c1[0], c1[1]); o.w = pk2(c1[2], c1[3]);
                        *(v4u*)(Cg + (size_t)(nb * 16 + lr) * 256 + wave * 32 + 8 * lg) = o; }
                }
                __syncthreads();
            }
        } break;
        case 3: { if (!((PHMASK >> 3) & 1)) break; PH_INIT
            LAS float* sA = (LAS float*)L; LAS float* sB = sA + 128; LAS float* sML = sA + 256; LAS float* sBL = sA + 384; LAS float* sM = sA + 512;
            for (int q0 = vcu * 512; q0 < 131072; q0 += G * 512) {
                const int chain = q0 >> 14, eb = q0 & 16383, e4 = eb + tid;
                if (tid < 128) { sML[tid] = MLOC[chain * 128 + tid]; sBL[tid] = BLAST[chain * 128 + tid]; }
                __syncthreads();
                if (tid == 0) { float m = 0.f;
                    for (int c = 0; c < 128; ++c) { sM[c] = m; m = fmaxf(sBL[c] + m, sML[c]); } sM[128] = m; }
                __syncthreads();
                if (tid < 128) { const float m0 = sM[tid], m1 = sM[tid + 1]; sA[tid] = __expf(sBL[tid] + m0 - m1); sB[tid] = __expf(sML[tid] - m1); if (eb == 0 && !dry) MST[chain * 128 + tid] = m0; }
                __syncthreads();
                {
                    unsigned long long* pp = (unsigned long long*)ST + (size_t)chain * 128 * 16384 + e4;
                    float C0 = 0.f, C1 = 0.f, C2 = 0.f, C3 = 0.f;
                    unsigned long long cur[16], nxt[16];
#pragma unroll
                    for (int j = 0; j < 16; ++j) cur[j] = pp[(size_t)j * 16384];
                    for (int c = 0; c < 128; c += 16) {
#pragma unroll
                        for (int j = 0; j < 16; ++j) { const int cn = (c + 16 + j < 128) ? c + 16 + j : 127; nxt[j] = pp[(size_t)cn * 16384]; }
#pragma unroll
                        for (int j = 0; j < 16; ++j) { const float a = sA[c + j], bs = sB[c + j];
                            const unsigned lo = pk2(C0, C1), hi = pk2(C2, C3);
                            if (!dry) pp[(size_t)(c + j) * 16384] = (unsigned long long)lo | ((unsigned long long)hi << 32);
                            const unsigned dlo = (unsigned)cur[j], dhi = (unsigned)(cur[j] >> 32);
                            C0 = a * C0 + bs * bflo(dlo); C1 = a * C1 + bs * bfhi(dlo); C2 = a * C2 + bs * bflo(dhi); C3 = a * C3 + bs * bfhi(dhi); }
#pragma unroll
                        for (int j = 0; j < 16; ++j) cur[j] = nxt[j];
                    }
                }
                if (tid < 8) {
                    float* pn = DN + (size_t)chain * 128 * 256 + (eb >> 9) * 8 + tid; float n = 0.f;
                    for (int c = 0; c < 128; c += 16) { float d[16];
#pragma unroll
                        for (int j = 0; j < 16; ++j) d[j] = pn[(size_t)(c + j) * 256];
#pragma unroll
                        for (int j = 0; j < 16; ++j) { if (!dry) pn[(size_t)(c + j) * 256] = n; n = sA[c + j] * n + sB[c + j] * d[j]; } }
                }
                __syncthreads();
            }
        } break;
        case 4: { if (!((PHMASK >> 4) & 1)) break; PH_INIT
            LAS bf16* Qs = (LAS bf16*)L; LAS bf16* Ks = (LAS bf16*)(L + 33792); LAS float* Sf = (LAS float*)(L + 67584); LAS bf16* VT = (LAS bf16*)(L + 84224);
            LAS bf16* Wt = (LAS bf16*)(L + 43008 + wave * 5120);
            LAS bf16* Pb = Ks;
            LAS float* bcs = (LAS float*)(L + 121088); LAS float* ii = bcs + 64; LAS float* AI = bcs + 128; LAS float* DEN = bcs + 192; LAS float* SSQ = bcs + 256; LAS float* DNs = bcs + 768;
            for (int u = vcu; u < 1024; u += G) {
                int tq_ = tid; asm volatile("" : "+v"(tq_)); const int ltid = tq_, llane = ltid & 63, llr = llane & 15, llg = llane >> 4;
                const int bh = u >> 7, c = u & 127, b = bh >> 2, h = bh & 3; const size_t r0 = (size_t)b * SEQ + c * 64;
                const bf16* Cg = ST + (size_t)u * 65536;
                const float mc = MST[u];
                if (ltid < 256) DNs[ltid] = DN[(size_t)u * 256 + ltid];
                {
                    const float ip = GATES[(r0 + llane) * 8 + h], fp = GATES[(r0 + llane) * 8 + 4 + h];
                    bcs[llane] = wave_prefix(log_sigmoid(fp), llane); ii[llane] = ip;
                }
                for (int it = ltid; it < 2048; it += 512) { const int s = it >> 5, d8 = it & 31; const size_t go = (r0 + s) * 1024 + h * 256 + d8 * 8;
                    const v4u qv = *(const v4u*)(PA + go), kv = *(const v4u*)(PA + TS + go);
                    *(LAS v4u*)(Qs + s * 264 + d8 * 8) = qv;
                    v4u ks; ks.x = pk2(bflo(kv.x) * 0.0625f, bfhi(kv.x) * 0.0625f); ks.y = pk2(bflo(kv.y) * 0.0625f, bfhi(kv.y) * 0.0625f); ks.z = pk2(bflo(kv.z) * 0.0625f, bfhi(kv.z) * 0.0625f); ks.w = pk2(bflo(kv.w) * 0.0625f, bfhi(kv.w) * 0.0625f);
                    *(LAS v4u*)(Ks + s * 264 + d8 * 8) = ks; }
#pragma unroll
                for (int i = 0; i < 2; ++i) { const int it = ltid + 512 * i, d8 = it >> 5, sp = it & 31; const size_t go = (r0 + 2 * sp) * 1024 + h * 256 + d8 * 8;
                    const v4u v0 = *(const v4u*)(PA + 2 * TS + go), v1 = *(const v4u*)(PA + 2 * TS + go + 1024);
                    LAS unsigned* vt = (LAS unsigned*)(VT + (d8 * 8) * 72 + 2 * sp);
#define VP4(F, J) vt[(J) * 36] = (v0.F & 0xffffu) | (v1.F << 16); vt[(J + 1) * 36] = (v0.F >> 16) | (v1.F & 0xffff0000u);
                    VP4(x, 0) VP4(y, 2) VP4(z, 4) VP4(w, 6)
#undef VP4
                }
                bf16x8 cfr[8][2];
#pragma unroll
                for (int kk = 0; kk < 8; ++kk)
#pragma unroll
                    for (int nbi = 0; nbi < 2; ++nbi) cfr[kk][nbi] = *(const bf16x8*)(Cg + (size_t)((wave * 2 + nbi) * 16 + llr) * 256 + (kk >> 1) * 64 + 16 * llg + 8 * (kk & 1));
                __syncthreads();
                {
                    const int tb = wave >> 1;
#pragma unroll
                    for (int sbi = 0; sbi < 2; ++sbi) { const int sb = (wave & 1) * 2 + sbi; f32x4 acc = {0.f, 0.f, 0.f, 0.f};
#pragma unroll
                        for (int kk = 0; kk < 8; ++kk) { const bf16x8 a = *(const LAS bf16x8*)(Qs + (tb * 16 + llr) * 264 + kk * 32 + 8 * llg), bb = *(const LAS bf16x8*)(Ks + (sb * 16 + llr) * 264 + kk * 32 + 8 * llg);
                            acc = __builtin_amdgcn_mfma_f32_16x16x32_bf16(a, bb, acc, 0, 0, 0); }
#pragma unroll
                        for (int r = 0; r < 4; ++r) Sf[(tb * 16 + 4 * llg + r) * 65 + sb * 16 + llr] = acc[r]; }
                }
                __syncthreads();
                {
                    const int t = ltid >> 3, part = ltid & 7; const float bt = bcs[t];
                    float d[8]; float mx = -INFINITY;
#pragma unroll
                    for (int j = 0; j < 8; ++j) { const int s = part * 8 + j; d[j] = (s <= t) ? (bt - bcs[s] + ii[s]) : -INFINITY; mx = fmaxf(mx, d[j]); }
                    mx = fmaxf(mx, __shfl_xor(mx, 1)); mx = fmaxf(mx, __shfl_xor(mx, 2)); mx = fmaxf(mx, __shfl_xor(mx, 4));
                    const float inter = bt + mc, mt = fmaxf(inter, mx);
                    float rs = 0.f; unsigned pw[4];
#pragma unroll
                    for (int j = 0; j < 8; j += 2) { const int s = part * 8 + j;
                        const float p0 = (s <= t) ? Sf[t * 65 + s] * __expf(d[j] - mt) : 0.f, p1 = (s + 1 <= t) ? Sf[t * 65 + s + 1] * __expf(d[j + 1] - mt) : 0.f;
                        rs += p0 + p1; pw[j >> 1] = pk2(p0, p1); }
                    v4u pv; pv.x = pw[0]; pv.y = pw[1]; pv.z = pw[2]; pv.w = pw[3];
                    rs += __shfl_xor(rs, 1); rs += __shfl_xor(rs, 2); rs += __shfl_xor(rs, 4);
                    float dq = 0.f; const LAS float* dn = DNs + part * 32;
#pragma unroll 8
                    for (int kk = 0; kk < 32; ++kk) dq += bf2f(Qs[t * 264 + part * 32 + kk]) * dn[kk];
                    dq += __shfl_xor(dq, 1); dq += __shfl_xor(dq, 2); dq += __shfl_xor(dq, 4);
                    const float ai = __expf(inter - mt);
                    *(LAS v4u*)(Pb + t * 72 + part * 8) = pv;
                    if (part == 0) { AI[t] = ai; DEN[t] = fmaxf(fabsf(rs + ai * dq), __expf(-mt)); }
                }
                __syncthreads();
                {
                    {
                        const bf16* Og = PA + 3 * TS;
#pragma unroll
                        for (int i = 0; i < 4; ++i) { const int row = i * 16 + (llane >> 2), ch = llane & 3;
                            const v4u w = *(const v4u*)(Og + (r0 + row) * 1024 + h * 256 + wave * 32 + ch * 8); *(LAS v4u*)(Wt + row * 40 + ch * 8) = w; }
                    }
                    f32x4 acc[4][2];
#pragma unroll
                    for (int tb = 0; tb < 4; ++tb) { acc[tb][0] = (f32x4){0.f, 0.f, 0.f, 0.f}; acc[tb][1] = (f32x4){0.f, 0.f, 0.f, 0.f}; }
#pragma unroll
                    for (int kk = 0; kk < 8; ++kk) {
                        bf16x8 bfr[2]; bfr[0] = cfr[kk][0]; bfr[1] = cfr[kk][1];
#pragma unroll
                        for (int tb = 0; tb < 4; ++tb) { const bf16x8 a = *(const LAS bf16x8*)(Qs + (tb * 16 + llr) * 264 + (kk >> 1) * 64 + 16 * llg + 8 * (kk & 1));
                            acc[tb][0] = __builtin_amdgcn_mfma_f32_16x16x32_bf16(a, bfr[0], acc[tb][0], 0, 0, 0);
                            acc[tb][1] = __builtin_amdgcn_mfma_f32_16x16x32_bf16(a, bfr[1], acc[tb][1], 0, 0, 0); }
                    }
#pragma unroll
                    for (int tb = 0; tb < 4; ++tb)
#pragma unroll
                        for (int r = 0; r < 4; ++r) { const float ai = AI[tb * 16 + 4 * llg + r]; acc[tb][0][r] *= ai; acc[tb][1][r] *= ai; }
#pragma unroll
                    for (int kk = 0; kk < 2; ++kk) {
                        bf16x8 bfr[2];
#pragma unroll
                        for (int nbi = 0; nbi < 2; ++nbi) bfr[nbi] = *(const LAS bf16x8*)(VT + ((wave * 2 + nbi) * 16 + llr) * 72 + kk * 32 + 8 * llg);
#pragma unroll
                        for (int tb = 0; tb < 4; ++tb) { const bf16x8 a = *(const LAS bf16x8*)(Pb + (tb * 16 + llr) * 72 + kk * 32 + 8 * llg);
                            acc[tb][0] = __builtin_amdgcn_mfma_f32_16x16x32_bf16(a, bfr[0], acc[tb][0], 0, 0, 0);
                            acc[tb][1] = __builtin_amdgcn_mfma_f32_16x16x32_bf16(a, bfr[1], acc[tb][1], 0, 0, 0); }
                    }
                    asm volatile("s_waitcnt lgkmcnt(0)" ::: "memory");
#pragma unroll
                    for (int tb = 0; tb < 4; ++tb)
#pragma unroll
                        for (int r = 0; r < 4; ++r) { const int t = tb * 16 + 4 * llg + r; const float inv = __builtin_amdgcn_rcpf(DEN[t]); float sq = 0.f;
#pragma unroll
                            for (int nbi = 0; nbi < 2; ++nbi) { const float og = bf2f(Wt[t * 40 + nbi * 16 + llr]);
                                const float y = acc[tb][nbi][r] * inv * __builtin_amdgcn_rcpf(1.0f + __expf(-og)); acc[tb][nbi][r] = y; sq += y * y; }
                            sq += __shfl_xor(sq, 1); sq += __shfl_xor(sq, 2); sq += __shfl_xor(sq, 4); sq += __shfl_xor(sq, 8);
                            if (llr == 0) SSQ[wave * 64 + t] = sq; }
                    __syncthreads();
                    const float* gn = ap->in[4] + l * 1024 + h * 256;
                    const float g0 = gn[wave * 32 + llr], g1 = gn[wave * 32 + 16 + llr];
#pragma unroll
                    for (int tb = 0; tb < 4; ++tb)
#pragma unroll
                        for (int r = 0; r < 4; ++r) { const int t = tb * 16 + 4 * llg + r; float tot = 0.f;
#pragma unroll
                            for (int w = 0; w < 8; ++w) tot += SSQ[w * 64 + t];
                            const float rstd = __builtin_amdgcn_rsqf(tot * (1.0f / 256.0f) + EPS);
                            Wt[t * 40 + llr] = f2bf(acc[tb][0][r] * rstd * g0); Wt[t * 40 + 16 + llr] = f2bf(acc[tb][1][r] * rstd * g1); }
                    asm volatile("s_waitcnt lgkmcnt(0)" ::: "memory");
#pragma unroll
                    for (int i = 0; i < 4; ++i) { const int row = i * 16 + (llane >> 2), ch = llane & 3;
                        *(v4u*)(YML + (r0 + row) * 1024 + h * 256 + wave * 32 + ch * 8) = *(const LAS v4u*)(Wt + row * 40 + ch * 8); }
                }
                __syncthreads();
            }
        } break;
        case 6: { if (!((PHMASK >> 6) & 1)) break; PH_INIT
            {
                if (tid == 0) *(LAS unsigned*)L = 0u;
                __syncthreads();
                const bf16* SCB = P2 + TS; const bf16* SCC = P2 + 2 * TS; const bf16* SCU = P2 + 3 * TS; bf16* YSC = (bf16*)(ws + WS_YSC);
                const float* cw = ap->in[5] + (size_t)l * 3 * 1024;
                if (wave < 4) for (int it = vcu * 256 + tid; it < M * 128; it += G * 256) { const int row = it >> 7, c8 = it & 127, t = row & (SEQ - 1); const size_t o = (size_t)row * 1024 + c8 * 8;
                    const v4u bv = *(const v4u*)(SCB + o), c0 = *(const v4u*)(SCC + o), u0 = *(const v4u*)(SCU + o);
                    v4u c1 = {0u, 0u, 0u, 0u}, u1 = c1, c2 = c1, u2 = c1;
                    if (t >= 1) { c1 = *(const v4u*)(SCC + o - 1024); u1 = *(const v4u*)(SCU + o - 1024); }
                    if (t >= 2) { c2 = *(const v4u*)(SCC + o - 2048); u2 = *(const v4u*)(SCU + o - 2048); }
                    const f32x4 w0a = *(const f32x4*)(cw + c8 * 8), w0b = *(const f32x4*)(cw + c8 * 8 + 4), w1a = *(const f32x4*)(cw + 1024 + c8 * 8), w1b = *(const f32x4*)(cw + 1024 + c8 * 8 + 4),
                                w2a = *(const f32x4*)(cw + 2048 + c8 * 8), w2b = *(const f32x4*)(cw + 2048 + c8 * 8 + 4);
                    v4u ov;
#define CONV2(F, WA, E0, E1) pk2(bflo(bv.F) * (WA##0[E0] * bflo(c2.F) * bflo(u2.F) + WA##1[E0] * bflo(c1.F) * bflo(u1.F) + WA##2[E0] * bflo(c0.F) * bflo(u0.F)), \
                                 bfhi(bv.F) * (WA##0[E1] * bfhi(c2.F) * bfhi(u2.F) + WA##1[E1] * bfhi(c1.F) * bfhi(u1.F) + WA##2[E1] * bfhi(c0.F) * bfhi(u0.F)))
                    const f32x4 wa0 = w0a, wa1 = w1a, wa2 = w2a, wb0 = w0b, wb1 = w1b, wb2 = w2b;
                    ov.x = CONV2(x, wa, 0, 1); ov.y = CONV2(y, wa, 2, 3); ov.z = CONV2(z, wb, 0, 1); ov.w = CONV2(w, wb, 2, 3);
#undef CONV2
                    *(v4u*)(YSC + o) = ov; }
            }
            {
                bf16* SBQ = P2; const bf16* SBK = P2 + 4 * TS; const bf16* VTg = P2 + 5 * TS;
                const int nU = (8192 - vcu + G - 1) / G;
                for (;;) { int j = 0; if (lane == 0) j = (int)__hip_atomic_fetch_add((LAS unsigned*)L, 1u, __ATOMIC_RELAXED, __HIP_MEMORY_SCOPE_WORKGROUP);
                    j = __builtin_amdgcn_readfirstlane(j); if (j >= nU) break; const int wu = vcu + G * j;
                    __builtin_amdgcn_s_setprio(2);
                    const int bh = wu >> 8, qt = wu & 255, b = bh >> 4, h = bh & 15, q0 = qt * 32;
                    bf16x8 qf[2][2];
#pragma unroll
                    for (int qb = 0; qb < 2; ++qb)
#pragma unroll
                        for (int kk = 0; kk < 2; ++kk) qf[qb][kk] = *(const bf16x8*)(SBQ + ((size_t)b * SEQ + q0 + qb * 16 + lr) * 1024 + h * 64 + kk * 32 + 8 * lg);
                    f32x4 o[2][4];
#pragma unroll
                    for (int qb = 0; qb < 2; ++qb)
#pragma unroll
                        for (int db = 0; db < 4; ++db) o[qb][db] = (f32x4){0.f, 0.f, 0.f, 0.f};
                    float R[2] = {0.f, 0.f};
                    const bf16* Kb = SBK + (size_t)b * SEQ * 1024 + h * 64 + 8 * lg;
                    const bf16* Vb = VTg + (size_t)(b * 1024 + h * 64 + lr) * SEQ + 4 * lg;
                    bf16x8 kfr[4][2];
                    { const int kt0 = (q0 >> 6) << 6;
#pragma unroll
                      for (int kb = 0; kb < 4; ++kb) { const bf16* kp = Kb + (size_t)(kt0 + kb * 16 + lr) * 1024; kfr[kb][0] = *(const bf16x8*)kp; kfr[kb][1] = *(const bf16x8*)(kp + 32); } }
                    for (int kt = (q0 >> 6) << 6; kt >= 0; kt -= 64) {
                        v2u vlo[2][4], vhi[2][4];
#pragma unroll
                        for (int kk2 = 0; kk2 < 2; ++kk2)
#pragma unroll
                            for (int db = 0; db < 4; ++db) { const bf16* vp = Vb + (size_t)(db * 16) * SEQ + kt + kk2 * 32; vlo[kk2][db] = *(const v2u*)vp; vhi[kk2][db] = *(const v2u*)(vp + 16); }
                        bf16x8 knx[4][2];
                        { const int ktn = kt >= 64 ? kt - 64 : 0;
#pragma unroll
                          for (int kb = 0; kb < 4; ++kb) { const bf16* kp = Kb + (size_t)(ktn + kb * 16 + lr) * 1024; knx[kb][0] = *(const bf16x8*)kp; knx[kb][1] = *(const bf16x8*)(kp + 32); } }
                        f32x4 st[4][2];
#pragma unroll
                        for (int kb = 0; kb < 4; ++kb) {
#pragma unroll
                            for (int qb = 0; qb < 2; ++qb) { f32x4 z4 = {0.f, 0.f, 0.f, 0.f};
                                z4 = __builtin_amdgcn_mfma_f32_16x16x32_bf16(kfr[kb][0], qf[qb][0], z4, 0, 0, 0);
                                st[kb][qb] = __builtin_amdgcn_mfma_f32_16x16x32_bf16(kfr[kb][1], qf[qb][1], z4, 0, 0, 0); } }
                        unsigned pp[2][4][2];
#pragma unroll
                        for (int qb = 0; qb < 2; ++qb) { const int tq = q0 + qb * 16 + lr;
                            float lpv[4][4], lbv[4][4], Hs[4], tot[4];
#pragma unroll
                            for (int kb = 0; kb < 4; ++kb) { float gs = 0.f;
                                if (kt + kb * 16 >= q0 + qb * 16 + 16) {
#pragma unroll
                                    for (int r = 0; r < 4; ++r) { lpv[kb][r] = 0.f; lbv[kb][r] = -INFINITY; }
                                } else if (kt + kb * 16 + 16 <= q0 + qb * 16) {
#pragma unroll
                                    for (int r = 0; r < 4; ++r) { const float z = st[kb][qb][r] * (0.125f * 1.4426950408889634f);
                                        const float sp = fmaxf(z, 0.f) + __builtin_amdgcn_logf(1.0f + __builtin_amdgcn_exp2f(-fabsf(z)));
                                        lpv[kb][r] = -sp; lbv[kb][r] = z - sp; gs -= sp; }
                                } else {
#pragma unroll
                                for (int r = 0; r < 4; ++r) { const int key = kt + kb * 16 + 4 * lg + r; const float z = st[kb][qb][r] * (0.125f * 1.4426950408889634f);
                                    const float sp = fmaxf(z, 0.f) + __builtin_amdgcn_logf(1.0f + __builtin_amdgcn_exp2f(-fabsf(z)));
                                    const bool act = key < tq; lpv[kb][r] = act ? -sp : 0.f; lbv[kb][r] = act ? z - sp : -INFINITY; gs += lpv[kb][r]; }
                                }
                                const float ga = __shfl_xor(gs, 16), gb = __shfl_xor(gs, 32), gc = __shfl_xor(gs, 48);
                                tot[kb] = (gs + ga) + (gb + gc);
                                Hs[kb] = (((lg ^ 1) > lg) ? ga : 0.f) + (((lg ^ 2) > lg) ? gb : 0.f) + (((lg ^ 3) > lg) ? gc : 0.f); }
                            float base = R[qb];
#pragma unroll
                            for (int kb = 3; kb >= 0; --kb) { float acc = base + Hs[kb]; float pa[4];
#pragma unroll
                                for (int r = 3; r >= 0; --r) { pa[r] = __builtin_amdgcn_exp2f(lbv[kb][r] + acc); acc += lpv[kb][r]; }
                                pp[qb][kb][0] = pk2(pa[0], pa[1]); pp[qb][kb][1] = pk2(pa[2], pa[3]); base += tot[kb]; }
                            R[qb] = base; }
#pragma unroll
                        for (int kk2 = 0; kk2 < 2; ++kk2) {
                            bf16x8 af[2];
#pragma unroll
                            for (int qb = 0; qb < 2; ++qb) { v4u t4; t4.x = pp[qb][2 * kk2][0]; t4.y = pp[qb][2 * kk2][1]; t4.z = pp[qb][2 * kk2 + 1][0]; t4.w = pp[qb][2 * kk2 + 1][1]; af[qb] = __builtin_bit_cast(bf16x8, t4); }
#pragma unroll
                            for (int db = 0; db < 4; ++db) { const v2u lo = vlo[kk2][db], hi = vhi[kk2][db];
                                v4u t4; t4.x = lo.x; t4.y = lo.y; t4.z = hi.x; t4.w = hi.y; const bf16x8 vb = __builtin_bit_cast(bf16x8, t4);
#pragma unroll
                                for (int qb = 0; qb < 2; ++qb) o[qb][db] = __builtin_amdgcn_mfma_f32_16x16x32_bf16(af[qb], vb, o[qb][db], 0, 0, 0); } }
                        if (__all(R[0] < SB_THR * 1.4426950408889634f && R[1] < SB_THR * 1.4426950408889634f)) break;
#pragma unroll
                        for (int kb = 0; kb < 4; ++kb) { kfr[kb][0] = knx[kb][0]; kfr[kb][1] = knx[kb][1]; }
                    }
                    __builtin_amdgcn_s_setprio(0);
                    if (!dry) {
#pragma unroll
                        for (int qb = 0; qb < 2; ++qb)
#pragma unroll
                            for (int db = 0; db < 4; ++db)
#pragma unroll
                                for (int r = 0; r < 4; ++r) SBQ[((size_t)b * SEQ + q0 + qb * 16 + 4 * lg + r) * 1024 + h * 64 + db * 16 + lr] = f2bf(o[qb][db][r]);
                    }
                }
            }
        } break;
        case 7: { if (!((PHMASK >> 7) & 1)) break; PH_INIT
            pg8::Gemm g{(const bf16*)(ws + WS_XN), (const bf16*)(ws + WS_WML), 3 * M, 3072, 1024}; pg8::GateSched S; S.base.init(M, 1024, G, bx);
            pg8::EpiGate E{P2 + (size_t)6 * TS, (float*)(ws + WS_MG), (bf16*)(ws + WS_MGB), TS};
            pg8::gemm_phase<pg8::EpiGate, pg8::GateSched, true, true>((PG8_LAS unsigned char*)L, g, S, E);
        } break;
        case 9: { if (!((PHMASK >> 9) & 1)) break; PH_INIT
            const int gw = vcu * 8 + wave, NGW = G * 8;
            for (int m = gw; m < M; m += 2 * NGW) { const int m1 = m + NGW;
                if (m1 < M) norm_row_pair<0>(out + (size_t)m * DM, out + (size_t)m1 * DM, ap->in[10] + l * DM, XN + (size_t)m * DM, XN + (size_t)m1 * DM, nullptr, nullptr, lane);
                else norm_row<0>(out + (size_t)m * DM, ap->in[10] + l * DM, XN + (size_t)m * DM, nullptr, nullptr, nullptr, nullptr, lane); }
        } break;
        default: { if (!((PHMASK >> 12) & 1)) break; PH_INIT
            const int gw = vcu * 8 + wave, NGW = G * 8;
            for (int m = gw; m < M; m += 2 * NGW) { const int m1 = m + NGW;
                if (m1 < M) norm_row_pair<2>(out + (size_t)m * DM, out + (size_t)m1 * DM, ap->in[13], nullptr, nullptr, out + (size_t)m * DM, out + (size_t)m1 * DM, lane);
                else norm_row<2>(out + (size_t)m * DM, ap->in[13], nullptr, out + (size_t)m * DM, nullptr, nullptr, nullptr, lane); }
        } break;
        }
        }
    }
}

#ifndef MK_PER_PHASE
#define MK_PER_PHASE 0
#endif
extern "C" void kernel_launch(void* const* d_in, const int* in_sizes, int n_in, void* d_out, int out_size, void* d_ws, size_t ws_size, hipStream_t stream) {
    static int grid = 0;
    if (grid == 0) {
        if (n_in != 14 || out_size != M * DM || ws_size < WS_END) { fprintf(stderr, "kernel_launch: unexpected shapes (n_in %d, out %d, ws %zu)\n", n_in, out_size, ws_size); grid = -1; return; }
        int dev = 0, cus = 0, per_cu = 0;
        hipGetDevice(&dev); hipDeviceGetAttribute(&cus, hipDeviceAttributeMultiprocessorCount, dev);
        if (hipFuncSetAttribute((const void*)mega, hipFuncAttributeMaxDynamicSharedMemorySize, LDS_BYTES) != hipSuccess) { fprintf(stderr, "kernel_launch: hipFuncSetAttribute failed\n"); grid = -1; return; }
        if (hipOccupancyMaxActiveBlocksPerMultiprocessor(&per_cu, (const void*)mega, 512, LDS_BYTES) != hipSuccess || per_cu < 1) { fprintf(stderr, "kernel_launch: occupancy query gave %d\n", per_cu); per_cu = 1; }
        (void)hipGetLastError();
        grid = cus * 1;
        fprintf(stderr, "kernel_launch: cus %d per_cu %d grid %d\n", cus, per_cu, grid);
    }
    if (grid < 0) return;
    if (hipMemsetAsync(d_ws, 0, 16384, stream) != hipSuccess) { fprintf(stderr, "kernel_launch: memset of the barrier words failed\n"); return; }
    Args a{};
    for (int i = 0; i < 14; ++i) a.in[i] = (const float*)d_in[i];
    a.out = (float*)d_out; a.ws = (unsigned char*)d_ws;
#if MK_PER_PHASE
    for (int p = 0; p < 2 * NPH + 1; ++p) { a.ph_lo = p; a.ph_hi = p + 1; hipLaunchKernelGGL(mega, dim3(grid), dim3(512), LDS_BYTES, stream, a); }
#else
    a.ph_lo = 0; a.ph_hi = 2 * NPH + 1;
    void* kargs[] = {&a};
    hipError_t e = hipLaunchCooperativeKernel((const void*)mega, dim3(grid), dim3(512), kargs, LDS_BYTES, stream);
    if (e != hipSuccess) fprintf(stderr, "kernel_launch: cooperative launch failed: %s (grid %d)\n", hipGetErrorString(e), grid);
#endif
}
```

```cpp
#include <hip/hip_runtime.h>
#include <hip/hip_cooperative_groups.h>
#include <cstdio>
#include <cstdint>
namespace cg = cooperative_groups;
namespace pg8 {
#define PG8_LAS __attribute__((address_space(3)))
typedef unsigned short bf16_t;
typedef short bf16x8 __attribute__((ext_vector_type(8)));
typedef float f32x4 __attribute__((ext_vector_type(4)));
typedef unsigned u32x4 __attribute__((ext_vector_type(4)));
constexpr int BM = 256, BK = 64, HALF = 128, HTB = HALF * BK * 2  , STAGE_BYTES = 8 * HTB, NXCD = 8, WGM = 4;

__host__ __device__ __forceinline__ int lds_byte(int r, int c) { const int st = (r >> 4) * 2 + (c >> 5), rr = r & 15, cc = c & 31, ob = rr * 64 + cc * 2; return st * 1024 + (ob ^ (((ob >> 9) & 1) << 5)); }
__host__ __device__ __forceinline__ void stage_rc(int b, int& R, int& C) { const int st = b / 1024, sb = b % 1024, swz = sb ^ (((sb >> 9) & 1) << 5); R = (st >> 1) * 16 + swz / 64; C = (st & 1) * 32 + (swz % 64) / 2; }
__host__ __device__ __forceinline__ int perm32(int rho) { const int n = rho >> 4, i = rho & 15; return 8 * (i >> 2) + 4 * n + (i & 3); }

struct Unit { int pm, pn; };
struct Gemm { const bf16_t* A; const bf16_t* Bt; int M, N, K; };

struct StaticOrder {
    int nM, nN, nwg, G, c;
    __host__ __device__ void init(int M, int N, int G_, int c_) { nM = M / BM; nN = N / BM; nwg = nM * nN; G = G_; c = c_; }
    __host__ __device__ bool next(int i, Unit& u) const {
        const long L = (long)i * G + c; if (L >= nwg) return false;
        int wgid = (int)L; { const int q = nwg / NXCD, r = nwg % NXCD, xcd = wgid % NXCD, off = wgid / NXCD; wgid = (xcd < r ? xcd * (q + 1) : r * (q + 1) + (xcd - r) * q) + off; }
        const int nig = WGM * nN, gid = wgid / nig, fm = gid * WGM, gsz = (nM - fm) < WGM ? (nM - fm) : WGM;
        u.pm = fm + ((wgid % nig) % gsz); u.pn = (wgid % nig) / gsz; return true;
    }
    __device__ __forceinline__ void a_ready(const Unit&) const {}
    __device__ __forceinline__ void done(const Unit&) const {}
};

__device__ __forceinline__ unsigned cvt_pk_bf16(float lo, float hi) { unsigned r; asm volatile("v_cvt_pk_bf16_f32 %0, %1, %2" : "=v"(r) : "v"(lo), "v"(hi)); return r; }
typedef float f32x2 __attribute__((ext_vector_type(2)));
__device__ __forceinline__ f32x2 gelu_pk(f32x2 v) {
    const f32x2 av = __builtin_elementwise_abs(v), d = av * 0.2316418882f + 1.0f;
    f32x2 t; t.x = __builtin_amdgcn_rcpf(d.x); t.y = __builtin_amdgcn_rcpf(d.y);
    f32x2 q = t * 0.5307027145f + (-0.7265760135f); q = q * t + 0.7107068705f; q = q * t + (-0.142248368f); q = q * t + 0.127414796f; q = q * t;
    const f32x2 s = (v * v) * (-0.72134752044f);
    f32x2 e; e.x = __builtin_amdgcn_exp2f(s.x); e.y = __builtin_amdgcn_exp2f(s.y);
    const f32x2 m = v * (q * e), r = v - m;
    f32x2 o; o.x = v.x < 0.f ? m.x : r.x; o.y = v.y < 0.f ? m.y : r.y; return o;
}

template <int ACT  > struct EpiBf16 {
    static constexpr bool PERM = true, AFTER_DRAIN = false; static_assert(ACT == 0 || ACT == 1, "EpiBf16: ACT is 0 (none) or 1 (gelu_pk)");
    bf16_t* O; int ldc; const float* bias; int split_cols; size_t split_stride; float scale0;
    __device__ __forceinline__ void operator()(const f32x4 (&acc)[2][2][4][2], const Unit& u, int wr, int wc, int fr, int fq) const {
        const int row0 = u.pm * BM + wr * 64 + fr; int colt = u.pn * BM; bf16_t* base = O;
        float sc = 1.f; if (split_cols) { const int t = colt / split_cols; base += (size_t)t * split_stride; colt -= t * split_cols; if (t == 0) sc = scale0; }
        const int col0 = colt + wc * 32 + 8 * fq, bcol0 = u.pn * BM + wc * 32 + 8 * fq;
        f32x4 bv[2][2];
#pragma unroll
        for (int bj = 0; bj < 2; ++bj)
#pragma unroll
            for (int n = 0; n < 2; ++n) bv[bj][n] = bias ? *(const f32x4*)(bias + bcol0 + bj * HALF + 4 * n) : (f32x4){0.f, 0.f, 0.f, 0.f};
#pragma unroll
        for (int ai = 0; ai < 2; ++ai)
#pragma unroll
            for (int m = 0; m < 4; ++m) { bf16_t* rowp = base + (size_t)(row0 + ai * HALF + m * 16) * ldc + col0;
#pragma unroll
                for (int bj = 0; bj < 2; ++bj) { f32x4 v0 = acc[ai][bj][m][0] + bv[bj][0], v1 = acc[ai][bj][m][1] + bv[bj][1];
                    if (ACT == 1) { f32x2 a = gelu_pk((f32x2){v0[0], v0[1]}), b = gelu_pk((f32x2){v0[2], v0[3]}), c = gelu_pk((f32x2){v1[0], v1[1]}), d = gelu_pk((f32x2){v1[2], v1[3]});
                        v0 = (f32x4){a.x, a.y, b.x, b.y}; v1 = (f32x4){c.x, c.y, d.x, d.y}; }
                    v0 = v0 * sc; v1 = v1 * sc; u32x4 w; w.x = cvt_pk_bf16(v0[0], v0[1]); w.y = cvt_pk_bf16(v0[2], v0[3]); w.z = cvt_pk_bf16(v1[0], v1[1]); w.w = cvt_pk_bf16(v1[2], v1[3]);
                    *(u32x4*)(rowp + bj * HALF) = w; } }
    }
};

struct PanelStats {
    unsigned* xbuf;
    unsigned* cnt;
    unsigned* tmo;
    int ntn; float eps;
    unsigned code;
    __device__ __forceinline__ bool run(const f32x4 (&v)[2][2][4][2], const Unit& u, int wr, int wc, int fr, int fq, PG8_LAS unsigned char* lds, int wid, int lane) const {
        typedef float f32x2v __attribute__((ext_vector_type(2)));
        PG8_LAS f32x2v* P = (PG8_LAS f32x2v*)lds;
        PG8_LAS f32x2v* S = (PG8_LAS f32x2v*)(lds + 8192);
        PG8_LAS unsigned* flag = (PG8_LAS unsigned*)(lds + 8192 + 2048);
#pragma unroll
        for (int ai = 0; ai < 2; ++ai)
#pragma unroll
            for (int m = 0; m < 4; ++m) {
                float s = 0.f;
#pragma unroll
                for (int bj = 0; bj < 2; ++bj)
#pragma unroll
                    for (int n = 0; n < 2; ++n) { const f32x4 x = v[ai][bj][m][n]; s += (x[0] + x[1]) + (x[2] + x[3]); }
                s += __shfl_xor(s, 16); s += __shfl_xor(s, 32);
                const float mw = s * (1.0f / 64.0f); float q = 0.f;
#pragma unroll
                for (int bj = 0; bj < 2; ++bj)
#pragma unroll
                    for (int n = 0; n < 2; ++n) { const f32x4 d = v[ai][bj][m][n] - mw; q += (d[0] * d[0] + d[1] * d[1]) + (d[2] * d[2] + d[3] * d[3]); }
                q += __shfl_xor(q, 16); q += __shfl_xor(q, 32);
                if (fq == 0) P[(ai * HALF + wr * 64 + m * 16 + fr) * 4 + wc] = (f32x2v){mw, q};
            }
        asm volatile("s_waitcnt lgkmcnt(0)" ::: "memory"); __builtin_amdgcn_s_barrier(); asm volatile("" ::: "memory");
#if defined(BROKEN_EXCHANGE_NO_WAIT)
#warning BROKEN CONTROL BUILD: the row-statistics exchange does not wait; results are wrong by design
        if (blockIdx.x >= 64) { const long long t0_ = clock64(); while (clock64() - t0_ < 60000) __builtin_amdgcn_s_sleep(8); }
#endif
        const int row = wid * 32 + (lane & 31);
        if (lane < 32) {
            const f32x2v a = P[row * 4 + 0], b = P[row * 4 + 1], c = P[row * 4 + 2], d = P[row * 4 + 3];
            const float mt = (a.x + b.x + c.x + d.x) * 0.25f;
            const float da = a.x - mt, db = b.x - mt, dc = c.x - mt, dd = d.x - mt;
            const float m2 = (a.y + b.y) + (c.y + d.y) + 64.0f * ((da * da + db * db) + (dc * dc + dd * dd));
            unsigned long long* slot = (unsigned long long*)xbuf + ((size_t)(u.pm * BM + row) * 4 + u.pn);
            __hip_atomic_store(slot, ((unsigned long long)__float_as_uint(m2) << 32) | __float_as_uint(mt), __ATOMIC_RELAXED, __HIP_MEMORY_SCOPE_AGENT);
        }
        asm volatile("s_waitcnt vmcnt(0)" ::: "memory");
        if (lane == 0) __hip_atomic_fetch_add(cnt + 64 * u.pm, 1u, __ATOMIC_RELAXED, __HIP_MEMORY_SCOPE_AGENT);
        if (wid == 0) {
            bool dead = false; const unsigned long long t0 = __builtin_amdgcn_s_memrealtime(); const unsigned want = 8u * (unsigned)ntn;
            for (;;) {
#if defined(BROKEN_EXCHANGE_NO_WAIT)
                break;
#endif
                if ((unsigned)__builtin_amdgcn_readfirstlane(__hip_atomic_load(cnt + 64 * u.pm, __ATOMIC_RELAXED, __HIP_MEMORY_SCOPE_AGENT)) >= want) break;
                if (__builtin_amdgcn_s_memrealtime() - t0 > 2000000ull) {
                    if (lane == 0) { unsigned expect = 0u; __hip_atomic_compare_exchange_strong(tmo + 1, &expect, code | (unsigned)(u.pm & 0xff), __ATOMIC_RELAXED, __ATOMIC_RELAXED, __HIP_MEMORY_SCOPE_AGENT);
                                     __hip_atomic_store(tmo, 1u, __ATOMIC_RELAXED, __HIP_MEMORY_SCOPE_AGENT); }
                    dead = true; break; }
                __builtin_amdgcn_s_sleep(2);
            }
            __builtin_amdgcn_fence(__ATOMIC_ACQUIRE, "agent");
            if (lane == 0) flag[0] = dead ? 1u : 0u;
        }
        asm volatile("s_waitcnt vmcnt(0) lgkmcnt(0)" ::: "memory"); __builtin_amdgcn_s_barrier(); asm volatile("" ::: "memory");
        const bool bad = flag[0] != 0u;
        if (lane < 32) {
            const unsigned long long* slot = (const unsigned long long*)xbuf + (size_t)(u.pm * BM + row) * 4; float mt[4], m2[4]; float ms = 0.f;
#pragma unroll
            for (int t = 0; t < 4; ++t) { if (t < ntn) { const unsigned long long w = __hip_atomic_load(slot + t, __ATOMIC_RELAXED, __HIP_MEMORY_SCOPE_AGENT); mt[t] = __uint_as_float((unsigned)w); m2[t] = __uint_as_float((unsigned)(w >> 32)); } else { mt[t] = 0.f; m2[t] = 0.f; } ms += mt[t]; }
            const float mean = ms / (float)ntn; float q = 0.f;
#pragma unroll
            for (int t = 0; t < 4; ++t) if (t < ntn) { const float dm = mt[t] - mean; q += m2[t] + 256.0f * dm * dm; }
            S[row] = (f32x2v){mean, 1.0f / sqrtf(q / (256.0f * (float)ntn) + eps)};
        }
        asm volatile("s_waitcnt lgkmcnt(0)" ::: "memory"); __builtin_amdgcn_s_barrier(); asm volatile("" ::: "memory");
        return bad;
    }
};
struct EpiLnRes {
    static constexpr bool PERM = false, AFTER_DRAIN = true;
    const float* base; float* out; int ldc; const float* bias; PanelStats st; unsigned poison;
    __device__ __forceinline__ void fused(f32x4 (&acc)[2][2][4][2], const Unit& u, int wr, int wc, int fr, int fq, PG8_LAS unsigned char* lds, int wid, int lane) const {
        typedef float f32x2v __attribute__((ext_vector_type(2)));
        const PG8_LAS f32x2v* S = (const PG8_LAS f32x2v*)(lds + 8192);
        const int col0 = u.pn * BM + wc * 32 + 4 * fq;
#pragma unroll
        for (int bj = 0; bj < 2; ++bj)
#pragma unroll
            for (int n = 0; n < 2; ++n) { const f32x4 bv = bias ? *(const f32x4*)(bias + col0 + bj * HALF + n * 16) : (f32x4){0.f, 0.f, 0.f, 0.f};
#pragma unroll
                for (int ai = 0; ai < 2; ++ai)
#pragma unroll
                    for (int m = 0; m < 4; ++m) acc[ai][bj][m][n] += bv; }
        f32x4 pre[4][2][2];
#pragma unroll
        for (int m = 0; m < 4; ++m) { const size_t off = (size_t)(u.pm * BM + wr * 64 + m * 16 + fr) * ldc + col0;
#pragma unroll
            for (int bj = 0; bj < 2; ++bj)
#pragma unroll
                for (int n = 0; n < 2; ++n) pre[m][bj][n] = *(const f32x4*)(base + off + bj * HALF + n * 16); }
        const bool bad = st.run(acc, u, wr, wc, fr, fq, lds, wid, lane) || poison != 0u;
        const float qnan = __builtin_nanf("");
#pragma unroll
        for (int ai = 0; ai < 2; ++ai)
#pragma unroll
            for (int m = 0; m < 4; ++m) { const int r = ai * HALF + wr * 64 + m * 16 + fr; const f32x2v sr = S[r]; const size_t off = (size_t)(u.pm * BM + r) * ldc + col0;
#pragma unroll
                for (int bj = 0; bj < 2; ++bj)
#pragma unroll
                    for (int n = 0; n < 2; ++n) { const f32x4 bs = ai == 0 ? pre[m][bj][n] : *(const f32x4*)(base + off + bj * HALF + n * 16); f32x4 o = bs + (acc[ai][bj][m][n] - sr.x) * sr.y;
                        if (bad) o = (f32x4){qnan, qnan, qnan, qnan}; *(f32x4*)(out + off + bj * HALF + n * 16) = o; }
                if (m & 1) asm volatile("" ::: "memory"); }
    }
};
struct EpiLnResLn {
    static constexpr bool PERM = false, AFTER_DRAIN = true;
    const float* base; float* out; bf16_t* xn; int ldc; const float* bias; PanelStats st1, st2; unsigned poison;
    __device__ __forceinline__ void fused(f32x4 (&acc)[2][2][4][2], const Unit& u, int wr, int wc, int fr, int fq, PG8_LAS unsigned char* lds, int wid, int lane) const {
        typedef float f32x2v __attribute__((ext_vector_type(2))); typedef unsigned u32x2v __attribute__((ext_vector_type(2)));
        const PG8_LAS f32x2v* S = (const PG8_LAS f32x2v*)(lds + 8192);
        const int col0 = u.pn * BM + wc * 32 + 4 * fq;
#pragma unroll
        for (int bj = 0; bj < 2; ++bj)
#pragma unroll
            for (int n = 0; n < 2; ++n) { const f32x4 bv = bias ? *(const f32x4*)(bias + col0 + bj * HALF + n * 16) : (f32x4){0.f, 0.f, 0.f, 0.f};
#pragma unroll
                for (int ai = 0; ai < 2; ++ai)
#pragma unroll
                    for (int m = 0; m < 4; ++m) acc[ai][bj][m][n] += bv; }
        bool bad = st1.run(acc, u, wr, wc, fr, fq, lds, wid, lane) || poison != 0u;
        const float qnan = __builtin_nanf("");
#pragma unroll
        for (int ai = 0; ai < 2; ++ai)
#pragma unroll
            for (int m = 0; m < 4; ++m) { const int r = ai * HALF + wr * 64 + m * 16 + fr; const f32x2v sr = S[r]; const size_t off = (size_t)(u.pm * BM + r) * ldc + col0;
#pragma unroll
                for (int bj = 0; bj < 2; ++bj)
#pragma unroll
                    for (int n = 0; n < 2; ++n) { const f32x4 bs = *(const f32x4*)(base + off + bj * HALF + n * 16); acc[ai][bj][m][n] = bs + (acc[ai][bj][m][n] - sr.x) * sr.y; }
                asm volatile("" : "+v"(acc[ai][0][m][0]), "+v"(acc[ai][0][m][1]), "+v"(acc[ai][1][m][0]), "+v"(acc[ai][1][m][1]));
                if (m & 1) asm volatile("" ::: "memory"); }
        const bool bad1 = bad;
        bad = st2.run(acc, u, wr, wc, fr, fq, lds, wid, lane) || bad;
#pragma unroll
        for (int ai = 0; ai < 2; ++ai)
#pragma unroll
            for (int m = 0; m < 4; ++m) { const int r = ai * HALF + wr * 64 + m * 16 + fr; const f32x2v sr = S[r]; const size_t off = (size_t)(u.pm * BM + r) * ldc + col0;
#pragma unroll
                for (int bj = 0; bj < 2; ++bj)
#pragma unroll
                    for (int n = 0; n < 2; ++n) { const f32x4 x1 = acc[ai][bj][m][n]; *(f32x4*)(out + off + bj * HALF + n * 16) = bad1 ? (f32x4){qnan, qnan, qnan, qnan} : x1;
                        const f32x4 o = (x1 - sr.x) * sr.y; u32x2v w; w.x = cvt_pk_bf16(o[0], o[1]); w.y = cvt_pk_bf16(o[2], o[3]);
                        if (bad) { w.x = 0x7fc07fc0u; w.y = 0x7fc07fc0u; } *(u32x2v*)(xn + off + bj * HALF + n * 16) = w; }
                asm volatile("" ::: "memory"); }
    }
};

template <class Epi, class Sched, bool ALIGN_EPI = false, bool SP2 = false>
__device__ __forceinline__ void gemm_phase(PG8_LAS unsigned char* lds, const Gemm g, const Sched& S, const Epi& E) {
    int tid_ = threadIdx.x; asm volatile("" : "+v"(tid_));
    const int tid = tid_, wid = __builtin_amdgcn_readfirstlane(tid >> 6), lane = tid & 63, wr = wid >> 2, wc = wid & 3, fr = lane & 15, fq = lane >> 4;
    const int K = g.K, nt = K / BK;
    unsigned voffA[2], voffB[2];
#pragma unroll
    for (int i = 0; i < 2; ++i) { int R, C; stage_rc(tid * 16 + i * 8192, R, C); const int Rb = Epi::PERM ? ((R & ~31) + perm32(R & 31)) : R;
        voffA[i] = (unsigned)(R * K + C) * 2u; voffB[i] = (unsigned)(Rb * K + C) * 2u; }
    const size_t kstep = (size_t)(BK * 2);
    const size_t hstep = (size_t)HALF * K * 2;
    const size_t tstep = 2 * hstep;
    const unsigned ldsw = (unsigned)wid * 1024u;
    const int aoff = lds_byte(wr * 64 + fr, fq * 8), boff = lds_byte(wc * 32 + fr, fq * 8);
#define PG8_SA(b, h) (((b) * 2 + (h)) * HTB)
#define PG8_SB(b, h) ((4 + (b) * 2 + (h)) * HTB)
#define PG8_STAGE(bufoff, gbase, voff) do { _Pragma("unroll") for (int _i = 0; _i < 2; ++_i) \
        __builtin_amdgcn_global_load_lds((const unsigned*)((const char*)(gbase) + (voff)[_i]), (PG8_LAS unsigned*)(lds + (bufoff) + ldsw + _i * 8192), 16, 0, 0); } while (0)
#define PG8_LDA(dst, b, h) do { _Pragma("unroll") for (int m = 0; m < 4; ++m) _Pragma("unroll") for (int k = 0; k < 2; ++k) dst[m][k] = *(const PG8_LAS bf16x8*)(lds + PG8_SA(b, h) + aoff + m * 2048 + k * 1024); } while (0)
#define PG8_LDB(dst, b, h) do { _Pragma("unroll") for (int n = 0; n < 2; ++n) _Pragma("unroll") for (int k = 0; k < 2; ++k) dst[n][k] = *(const PG8_LAS bf16x8*)(lds + PG8_SB(b, h) + boff + n * 2048 + k * 1024); } while (0)
#define PG8_MMA(ai, bj, At, Bt) do { __builtin_amdgcn_s_setprio(1); _Pragma("unroll") for (int m = 0; m < 4; ++m) _Pragma("unroll") for (int n = 0; n < 2; ++n) _Pragma("unroll") for (int k = 0; k < 2; ++k) \
        acc[ai][bj][m][n] = __builtin_amdgcn_mfma_f32_16x16x32_bf16(Bt[n][k], At[m][k], acc[ai][bj][m][n], 0, 0, 0); __builtin_amdgcn_s_setprio(0); } while (0)
#define PG8_WAIT_V(n) asm volatile("s_waitcnt vmcnt(" #n ")" ::: "memory")
#define PG8_WAIT_L(n) asm volatile("s_waitcnt lgkmcnt(" #n ")" ::: "memory")
#define PG8_BAR __builtin_amdgcn_s_barrier()
#define PG8_SCHED __builtin_amdgcn_sched_barrier(0)
    Unit cur, nxt; int ui = 0;
    if (!S.next(0, cur)) return;
    f32x4 acc[2][2][4][2];
#pragma unroll
    for (int a = 0; a < 2; ++a)
#pragma unroll
        for (int b = 0; b < 2; ++b)
#pragma unroll
            for (int m = 0; m < 4; ++m)
#pragma unroll
                for (int n = 0; n < 2; ++n) acc[a][b][m][n] = (f32x4){0.f, 0.f, 0.f, 0.f};
    bf16x8 At[4][2], B0[2][2], B1[2][2];
    const char* cA = (const char*)g.A + (size_t)cur.pm * tstep; const char* cB = (const char*)g.Bt + (size_t)cur.pn * tstep;
    S.a_ready(cur);
    if constexpr (SP2) {
        PG8_STAGE(PG8_SB(0, 0), cB, voffB); PG8_STAGE(PG8_SB(0, 1), cB + hstep, voffB); PG8_STAGE(PG8_SA(0, 0), cA, voffA); PG8_STAGE(PG8_SA(0, 1), cA + hstep, voffA);
        if (wr == 1) PG8_BAR;
        PG8_WAIT_V(2); PG8_BAR;
        PG8_STAGE(PG8_SB(1, 0), cB + kstep, voffB); PG8_STAGE(PG8_SA(1, 0), cA + kstep, voffA); PG8_STAGE(PG8_SB(1, 1), cB + hstep + kstep, voffB);
        PG8_WAIT_V(6); PG8_BAR;
    } else {
        PG8_STAGE(PG8_SB(0, 0), cB, voffB); PG8_STAGE(PG8_SA(0, 0), cA, voffA); PG8_STAGE(PG8_SB(0, 1), cB + hstep, voffB); PG8_STAGE(PG8_SA(0, 1), cA + hstep, voffA);
        if (wr == 1) PG8_BAR;
        PG8_WAIT_V(4); PG8_BAR;
        PG8_STAGE(PG8_SB(1, 0), cB + kstep, voffB); PG8_STAGE(PG8_SA(1, 0), cA + kstep, voffA); PG8_STAGE(PG8_SB(1, 1), cB + hstep + kstep, voffB);
        PG8_WAIT_V(6); PG8_BAR;
    }
    for (;;) {
        const bool has_next = S.next(ui + 1, nxt);
        const char* nA = has_next ? (const char*)g.A + (size_t)nxt.pm * tstep : cA; const char* nB = has_next ? (const char*)g.Bt + (size_t)nxt.pn * tstep : cB;
        for (int t = 0; t < nt; t += 2) {
            const bool last = (t == nt - 2);
            const char* a1 = cA + (size_t)(t + 1) * kstep;
            const char* a2 = last ? nA : cA + (size_t)(t + 2) * kstep; const char* b2 = last ? nB : cB + (size_t)(t + 2) * kstep;
            const char* a3 = a2 + kstep; const char* b3 = b2 + kstep;
            if (last && has_next) S.a_ready(nxt);
            if constexpr (SP2) {
            PG8_LDB(B0, 0, 0); PG8_LDB(B1, 0, 1); PG8_SCHED; PG8_LDA(At, 0, 0); PG8_STAGE(PG8_SA(1, 1), a1 + hstep, voffA);
            PG8_WAIT_V(8); PG8_WAIT_L(0); PG8_BAR; PG8_MMA(0, 0, At, B0); PG8_MMA(0, 1, At, B1); PG8_BAR; PG8_SCHED;
            PG8_LDA(At, 0, 1); PG8_STAGE(PG8_SB(0, 0), b2, voffB); PG8_STAGE(PG8_SB(0, 1), b2 + hstep, voffB); PG8_STAGE(PG8_SA(0, 0), a2, voffA);
            PG8_WAIT_V(8); PG8_WAIT_L(0); PG8_BAR; PG8_MMA(1, 0, At, B0); PG8_MMA(1, 1, At, B1); PG8_BAR; PG8_SCHED;
            PG8_LDB(B0, 1, 0); PG8_LDB(B1, 1, 1); PG8_SCHED; PG8_LDA(At, 1, 0); PG8_STAGE(PG8_SA(0, 1), a2 + hstep, voffA);
            PG8_WAIT_V(8); PG8_WAIT_L(0); PG8_BAR; PG8_MMA(0, 0, At, B0); PG8_MMA(0, 1, At, B1); PG8_BAR; PG8_SCHED;
            PG8_LDA(At, 1, 1); PG8_STAGE(PG8_SB(1, 0), b3, voffB); PG8_STAGE(PG8_SB(1, 1), b3 + hstep, voffB); PG8_STAGE(PG8_SA(1, 0), a3, voffA);
            PG8_WAIT_V(8); PG8_WAIT_L(0); PG8_BAR; PG8_MMA(1, 0, At, B0); PG8_MMA(1, 1, At, B1); PG8_BAR; PG8_SCHED;
            } else {
            PG8_LDB(B0, 0, 0); PG8_SCHED; PG8_LDA(At, 0, 0); PG8_STAGE(PG8_SA(1, 1), a1 + hstep, voffA);
            PG8_WAIT_L(8); PG8_BAR; PG8_WAIT_L(0); PG8_MMA(0, 0, At, B0); PG8_BAR; PG8_SCHED;
            PG8_LDB(B1, 0, 1); PG8_STAGE(PG8_SB(0, 0), b2, voffB);
            PG8_BAR; PG8_WAIT_L(0); PG8_MMA(0, 1, At, B1); PG8_BAR;
            PG8_LDA(At, 0, 1); PG8_STAGE(PG8_SA(0, 0), a2, voffA);
            PG8_BAR; PG8_WAIT_L(0); PG8_MMA(1, 0, At, B0); PG8_BAR; PG8_SCHED;
            PG8_STAGE(PG8_SB(0, 1), b2 + hstep, voffB);
            PG8_WAIT_V(6); PG8_BAR; PG8_MMA(1, 1, At, B1); PG8_BAR;
            PG8_LDB(B0, 1, 0); PG8_SCHED; PG8_LDA(At, 1, 0); PG8_STAGE(PG8_SA(0, 1), a2 + hstep, voffA);
            PG8_WAIT_L(8); PG8_BAR; PG8_WAIT_L(0); PG8_MMA(0, 0, At, B0); PG8_BAR; PG8_SCHED;
            PG8_LDB(B1, 1, 1); PG8_STAGE(PG8_SB(1, 0), b3, voffB);
            PG8_BAR; PG8_WAIT_L(0); PG8_MMA(0, 1, At, B1); PG8_BAR;
            PG8_LDA(At, 1, 1); PG8_STAGE(PG8_SA(1, 0), a3, voffA);
            PG8_BAR; PG8_WAIT_L(0); PG8_MMA(1, 0, At, B0); PG8_BAR; PG8_SCHED;
            PG8_STAGE(PG8_SB(1, 1), b3 + hstep, voffB);
            PG8_WAIT_V(6); PG8_BAR; PG8_MMA(1, 1, At, B1); PG8_BAR;
            }
        }
        if constexpr (ALIGN_EPI) { if (wr == 0) PG8_BAR; }
        if constexpr (!Epi::AFTER_DRAIN) { E(acc, cur, wr, wc, fr, fq); S.done(cur); }
        if (!has_next) break;
#pragma unroll
        for (int a = 0; a < 2; ++a)
#pragma unroll
            for (int b = 0; b < 2; ++b)
#pragma unroll
                for (int m = 0; m < 4; ++m)
#pragma unroll
                    for (int n = 0; n < 2; ++n) acc[a][b][m][n] = (f32x4){0.f, 0.f, 0.f, 0.f};
        cur = nxt; cA = nA; cB = nB; ++ui;
        if constexpr (ALIGN_EPI) { if (wr == 1) PG8_BAR; }
    }
    PG8_WAIT_V(0);
    if constexpr (!ALIGN_EPI) { if (wr == 0) PG8_BAR; }
    PG8_BAR;
    if constexpr (Epi::AFTER_DRAIN) { E.fused(acc, cur, wr, wc, fr, fq, lds, wid, lane); S.done(cur); }
#undef PG8_SA
#undef PG8_SB
#undef PG8_STAGE
#undef PG8_LDA
#undef PG8_LDB
#undef PG8_MMA
#undef PG8_WAIT_V
#undef PG8_WAIT_L
#undef PG8_BAR
#undef PG8_SCHED
}
}
namespace pg8 {
typedef float f32x2c __attribute__((ext_vector_type(2))); typedef __bf16 bf16x2c __attribute__((ext_vector_type(2)));
__device__ __forceinline__ unsigned cvt2(float lo, float hi) { f32x2c v = {lo, hi}; bf16x2c b = __builtin_convertvector(v, bf16x2c); return __builtin_bit_cast(unsigned, b); }
struct EpiStore {
    static constexpr bool PERM = true, AFTER_DRAIN = false;
    bf16_t* O; int ldc; int split_cols; size_t split_stride; int act; int act_from; int tr_tile;
    __device__ __forceinline__ void operator()(const f32x4 (&acc)[2][2][4][2], const Unit& u, int wr, int wc, int fr, int fq) const {
        const int row0 = u.pm * BM + wr * 64 + fr; int colt = u.pn * BM; bf16_t* base = O; int a = act;
        bool tr = false;
        if (split_cols) { const int t = colt / split_cols; base += (size_t)t * split_stride; colt -= t * split_cols; if (act == 1 && t < act_from) a = 0; tr = (t == tr_tile); }
        const int col0 = colt + wc * 32 + 8 * fq;
        if (tr) {
#pragma unroll
            for (int ai = 0; ai < 2; ++ai)
#pragma unroll
                for (int m = 0; m < 4; ++m) { const int row = row0 + ai * HALF + m * 16; bf16_t* cp = base + ((size_t)(row >> 13) * 1024 + col0) * 8192 + (row & 8191);
#pragma unroll
                    for (int bj = 0; bj < 2; ++bj)
#pragma unroll
                        for (int n = 0; n < 2; ++n)
#pragma unroll
                            for (int e = 0; e < 4; ++e) cp[(size_t)(bj * HALF + 4 * n + e) * 8192] = (bf16_t)(cvt2(acc[ai][bj][m][n][e], 0.f) & 0xffffu); }
            return;
        }
#pragma unroll
        for (int ai = 0; ai < 2; ++ai)
#pragma unroll
            for (int m = 0; m < 4; ++m) { bf16_t* rowp = base + (size_t)(row0 + ai * HALF + m * 16) * ldc + col0;
#pragma unroll
                for (int bj = 0; bj < 2; ++bj) { f32x4 v0 = acc[ai][bj][m][0], v1 = acc[ai][bj][m][1];
                    if (a == 1) {
#pragma unroll
                        for (int e = 0; e < 4; ++e) { v0[e] = __builtin_amdgcn_rcpf(1.0f + __expf(-v0[e])); v1[e] = __builtin_amdgcn_rcpf(1.0f + __expf(-v1[e])); }
                    } else if (a == 2) {
#pragma unroll
                        for (int e = 0; e < 4; ++e) { float p = fmaxf(v0[e], 0.f), q = fmaxf(v1[e], 0.f); v0[e] = p * p; v1[e] = q * q; }
                    }
                    u32x4 w; w.x = cvt2(v0[0], v0[1]); w.y = cvt2(v0[2], v0[3]); w.z = cvt2(v1[0], v1[1]); w.w = cvt2(v1[2], v1[3]);
                    *(u32x4*)(rowp + bj * HALF) = w; } }
    }
};
struct GateSched {
    StaticOrder base;
    __device__ __forceinline__ bool next(int i, Unit& u) const { Unit ub; if (!base.next(i / 3, ub)) return false; const int br = i % 3; u.pm = ub.pm + 64 * br; u.pn = ub.pn + 4 * br; return true; }
    __device__ __forceinline__ void a_ready(const Unit&) const {}
    __device__ __forceinline__ void done(const Unit&) const {}
};
struct EpiGate {
    static constexpr bool PERM = true, AFTER_DRAIN = false;
    const bf16_t* G; float* MG; bf16_t* MGb; size_t gstride;
    __device__ __forceinline__ void operator()(const f32x4 (&acc)[2][2][4][2], const Unit& u, int wr, int wc, int fr, int fq) const {
        const int mode = u.pm >> 6, pm = u.pm & 63, pn = u.pn & 3; const bf16_t* Gb = G + (size_t)mode * gstride;
        const int row0 = pm * BM + wr * 64 + fr; const int col0 = pn * BM + wc * 32 + 8 * fq;
#pragma unroll
        for (int ai = 0; ai < 2; ++ai)
#pragma unroll
            for (int m = 0; m < 4; ++m) { const size_t off = (size_t)(row0 + ai * HALF + m * 16) * 1024 + col0;
#pragma unroll
                for (int bj = 0; bj < 2; ++bj) { const size_t o2 = off + bj * HALF;
                    const u32x4 gw = *(const u32x4*)(Gb + o2);
                    f32x4 g0, g1;
                    g0[0] = __uint_as_float(gw.x << 16); g0[1] = __uint_as_float(gw.x & 0xffff0000u); g0[2] = __uint_as_float(gw.y << 16); g0[3] = __uint_as_float(gw.y & 0xffff0000u);
                    g1[0] = __uint_as_float(gw.z << 16); g1[1] = __uint_as_float(gw.z & 0xffff0000u); g1[2] = __uint_as_float(gw.w << 16); g1[3] = __uint_as_float(gw.w & 0xffff0000u);
                    f32x4 v0 = acc[ai][bj][m][0] * g0, v1 = acc[ai][bj][m][1] * g1;
                    if (mode != 0) { const u32x4 pw = *(const u32x4*)(MGb + o2);
                        v0[0] += __uint_as_float(pw.x << 16); v0[1] += __uint_as_float(pw.x & 0xffff0000u); v0[2] += __uint_as_float(pw.y << 16); v0[3] += __uint_as_float(pw.y & 0xffff0000u);
                        v1[0] += __uint_as_float(pw.z << 16); v1[1] += __uint_as_float(pw.z & 0xffff0000u); v1[2] += __uint_as_float(pw.w << 16); v1[3] += __uint_as_float(pw.w & 0xffff0000u); }
                    u32x4 w; w.x = cvt2(v0[0], v0[1]); w.y = cvt2(v0[2], v0[3]); w.z = cvt2(v1[0], v1[1]); w.w = cvt2(v1[2], v1[3]); *(u32x4*)(MGb + o2) = w; } }
    }
};
struct EpiRes {
    static constexpr bool PERM = false, AFTER_DRAIN = false;
    const float* base; float* out;
    __device__ __forceinline__ void operator()(const f32x4 (&acc)[2][2][4][2], const Unit& u, int wr, int wc, int fr, int fq) const {
        const int col0 = u.pn * BM + wc * 32 + 4 * fq;
#pragma unroll
        for (int ai = 0; ai < 2; ++ai)
#pragma unroll
            for (int m = 0; m < 4; ++m) { const size_t off = (size_t)(u.pm * BM + ai * HALF + wr * 64 + m * 16 + fr) * 1024 + col0;
#pragma unroll
                for (int bj = 0; bj < 2; ++bj)
#pragma unroll
                    for (int n = 0; n < 2; ++n) { const f32x4 bs = *(const f32x4*)(base + off + bj * HALF + n * 16); *(f32x4*)(out + off + bj * HALF + n * 16) = bs + acc[ai][bj][m][n]; } }
    }
};
}
constexpr int BATCH = 2, SEQ = 8192, DM = 1024, M = BATCH * SEQ, NIN = 13320, FF = 4096;
constexpr float EPS = 1e-6f;
constexpr float SB_THR = -30.0f;
constexpr size_t MiB = 1u << 20;
constexpr size_t WS_GATES = 1 * MiB;
constexpr size_t WS_MLOC = 1 * MiB + 512 * 1024, WS_BLAST = WS_MLOC + 4096, WS_MST = WS_BLAST + 4096;
constexpr size_t WS_WIN = 2 * MiB, WS_WML = 28 * MiB, WS_WSC = 30 * MiB, WS_WSB = 32 * MiB, WS_WOUT = 34 * MiB, WS_WUP = 36 * MiB, WS_WDN = 44 * MiB;
constexpr size_t WS_XN = 52 * MiB, WS_YML = 84 * MiB, WS_BIG = 116 * MiB;
constexpr size_t WS_PA = WS_BIG;
constexpr size_t WS_ST = 244 * MiB, WS_DN = 372 * MiB;
constexpr size_t WS_P2 = WS_BIG;
constexpr size_t WS_YSC = WS_XN, WS_YSB = WS_P2;
constexpr size_t WS_MG = WS_BIG + 32 * MiB, WS_MGB = WS_BIG + 96 * MiB, WS_HB = WS_BIG + 128 * MiB;
constexpr size_t WS_END = 404 * MiB;
constexpr int LDS_BYTES = 147456;
constexpr int NPH = 12;

#ifndef DRYLVL
#define DRYLVL 0
#endif
#ifndef DUP_MASK
#define DUP_MASK 0
#endif
#ifndef PHMASK
#define PHMASK 0x1fff
#endif
#define LAS __attribute__((address_space(3)))
typedef unsigned short bf16;
typedef unsigned v4u __attribute__((ext_vector_type(4)));
typedef unsigned v2u __attribute__((ext_vector_type(2)));
typedef float f32x4 __attribute__((ext_vector_type(4)));
typedef short bf16x8 __attribute__((ext_vector_type(8)));
__device__ __forceinline__ float bflo(unsigned w) { return __uint_as_float(w << 16); }
__device__ __forceinline__ float bfhi(unsigned w) { return __uint_as_float(w & 0xffff0000u); }
__device__ __forceinline__ float bf2f(unsigned short h) { return __uint_as_float((unsigned)h << 16); }
typedef float f32x2_t __attribute__((ext_vector_type(2))); typedef __bf16 bf16x2_t __attribute__((ext_vector_type(2)));
__device__ __forceinline__ unsigned pk2(float lo, float hi) { f32x2_t v = {lo, hi}; bf16x2_t b = __builtin_convertvector(v, bf16x2_t); return __builtin_bit_cast(unsigned, b); }
__device__ __forceinline__ unsigned short f2bf(float f) { return (unsigned short)(pk2(f, 0.f) & 0xffffu); }
__device__ __forceinline__ float wave_sum(float v) {
#pragma unroll
    for (int o = 1; o < 64; o <<= 1) v += __shfl_xor(v, o);
    return v;
}
__device__ __forceinline__ float wave_max(float v) {
#pragma unroll
    for (int o = 1; o < 64; o <<= 1) v = fmaxf(v, __shfl_xor(v, o));
    return v;
}
__device__ __forceinline__ float wave_prefix(float v, int lane) {
#pragma unroll
    for (int o = 1; o < 64; o <<= 1) { const float n = __shfl_up(v, o); if (lane >= o) v += n; }
    return v;
}
__device__ __forceinline__ float log_sigmoid(float x) { return fminf(x, 0.f) - __logf(1.0f + __expf(-fabsf(x))); }

#define XB_TMO      128
#define XB_XCNT(j)  (256  + 64 * (j))
#define XB_XSUB(j)  (1280 + 64 * (j))
#define XB_XGEN(j)  (2304 + 64 * (j))
#define XB_TOP      3328
#define XB_TOPGEN   3392
#define XCD_BAR_WORDS 3456
#define XB_SPIN_CAP (1u << 18)

__device__ __forceinline__ unsigned xb_ld(unsigned* p)              { return __hip_atomic_load(p, __ATOMIC_RELAXED, __HIP_MEMORY_SCOPE_AGENT); }
__device__ __forceinline__ unsigned xb_add(unsigned* p, unsigned v) { return __hip_atomic_fetch_add(p, v, __ATOMIC_RELAXED, __HIP_MEMORY_SCOPE_AGENT); }
__device__ __forceinline__ unsigned xb_xcc_id() { return (unsigned)__builtin_amdgcn_s_getreg((3 << 11) | 20) & 0xFu; }
#define XB_SPIN(cond, bar) do { unsigned _sp = 0; while (cond) { __builtin_amdgcn_s_sleep(1); \
    if ((++_sp & 255u) == 0u) { if (xb_ld(&(bar)[XB_TMO])) break; if (_sp > XB_SPIN_CAP) { atomicAdd(&(bar)[XB_TMO], 1u); break; } } } } while (0)

struct XcdBarrier {
    unsigned* bar; unsigned x;
    volatile LAS unsigned* st;
};

__device__ __forceinline__ XcdBarrier xcd_barrier_post(unsigned* bar, volatile LAS unsigned* st) {
    XcdBarrier b; b.bar = bar; b.x = xb_xcc_id(); b.st = st;
    if (threadIdx.x == 0) (void)xb_add(&bar[XB_XCNT(b.x)], 1u);
    return b;
}
__device__ __forceinline__ void xcd_barrier_complete(unsigned* bar, unsigned x, unsigned& nloc, unsigned& nx) {
    const unsigned G = gridDim.x * gridDim.y * gridDim.z;
    unsigned sum, cnt, mine, sp = 0u;
    for (;;) {
        sum = 0u; cnt = 0u; mine = 0u;
#pragma unroll
        for (unsigned j = 0; j < 16; ++j) { const unsigned c = xb_ld(&bar[XB_XCNT(j)]); sum += c; cnt += (c > 0u) ? 1u : 0u; mine = (j == x) ? c : mine; }
        if (sum == G) break;
        __builtin_amdgcn_s_sleep(1);
        if ((++sp & 255u) == 0u) { if (xb_ld(&bar[XB_TMO])) break; if (sp > XB_SPIN_CAP) { atomicAdd(&bar[XB_TMO], 1u); break; } }
    }
    nloc = mine > 0u ? mine : 1u; nx = cnt > 0u ? cnt : 1u;
}

__device__ __forceinline__ void xcd_barrier(const XcdBarrier& b) {
    asm volatile("s_waitcnt vmcnt(0)" ::: "memory");
    __syncthreads();
    if (threadIdx.x == 0) {
        unsigned* bar = b.bar;
        __builtin_amdgcn_s_waitcnt(0);
        unsigned nloc = b.st[0], nx = b.st[1];
        if (nloc == 0u) { xcd_barrier_complete(bar, b.x, nloc, nx); b.st[0] = nloc; b.st[1] = nx; }
        const unsigned old = xb_add(&bar[XB_XSUB(b.x)], 1u);
        const unsigned gen = old / nloc;
        if (old + 1u == (gen + 1u) * nloc) {
            __builtin_amdgcn_fence(__ATOMIC_RELEASE, "agent");
            asm volatile("s_waitcnt vmcnt(0)" ::: "memory");
            const unsigned og = xb_add(&bar[XB_TOP], 1u);
            const unsigned tg = og / nx;
            if (og + 1u == (tg + 1u) * nx) xb_add(&bar[XB_TOPGEN], 1u);
            else XB_SPIN(xb_ld(&bar[XB_TOPGEN]) == tg, bar);
            __builtin_amdgcn_fence(__ATOMIC_ACQUIRE, "agent");
            xb_add(&bar[XB_XGEN(b.x)], 1u);
            asm volatile("s_waitcnt vmcnt(0)" ::: "memory");
        } else {
            XB_SPIN(xb_ld(&bar[XB_XGEN(b.x)]) == gen, bar);
            __builtin_amdgcn_fence(__ATOMIC_ACQUIRE, "agent");
            asm volatile("s_waitcnt vmcnt(0)" ::: "memory");
        }
    }
    __syncthreads();
}

constexpr int MISC_OFF = 131072 + 320;
struct Args { const float* in[14]; float* out; unsigned char* ws; int ph_lo, ph_hi; };

__device__ __forceinline__ void transpose_item(const float* W, int pitch, int ncols, int K, bf16* WT, int row_off, LAS float* scr, int item, int lane) {
    const int nblk = ncols / 32, kb = item / nblk, nb = item % nblk, k0 = 64 * kb, n0 = 32 * nb;
    f32x4 wv[8];
#pragma unroll
    for (int i = 0; i < 8; ++i) wv[i] = *(const f32x4*)(W + (size_t)(k0 + 8 * i + (lane >> 3)) * pitch + n0 + 4 * (lane & 7));
#pragma unroll
    for (int i = 0; i < 8; ++i) { LAS float* d = scr + (8 * i + (lane >> 3)) * 33 + 4 * (lane & 7); d[0] = wv[i].x; d[1] = wv[i].y; d[2] = wv[i].z; d[3] = wv[i].w; }
    asm volatile("s_waitcnt lgkmcnt(0)" ::: "memory");
    const int c = lane & 7;
#pragma unroll
    for (int j = 0; j < 4; ++j) { const int n = (lane >> 3) + 8 * j; const LAS float* s = scr + (8 * c) * 33 + n;
        v4u o; o.x = pk2(s[0 * 33], s[1 * 33]); o.y = pk2(s[2 * 33], s[3 * 33]); o.z = pk2(s[4 * 33], s[5 * 33]); o.w = pk2(s[6 * 33], s[7 * 33]);
        *(v4u*)(WT + (size_t)(row_off + n0 + n) * K + k0 + 8 * c) = o; }
    asm volatile("s_waitcnt lgkmcnt(0)" ::: "memory");
}

template <int MODE>
__device__ __forceinline__ void norm_row(const float* xrow, const float* gain, bf16* orow, float* frow, const LAS float* Wg, const float* bias, float* grow, int lane) {
    const f32x4* xr = (const f32x4*)xrow + lane; const f32x4* gr = (const f32x4*)gain + lane;
    f32x4 v[4]; float s = 0.f;
#pragma unroll
    for (int j = 0; j < 4; ++j) { v[j] = xr[64 * j]; s += (v[j].x * v[j].x + v[j].y * v[j].y) + (v[j].z * v[j].z + v[j].w * v[j].w); }
    const float rstd = __builtin_amdgcn_rsqf(wave_sum(s) * (1.0f / DM) + EPS);
#pragma unroll
    for (int j = 0; j < 4; ++j) v[j] = v[j] * rstd * gr[64 * j];
    if (MODE == 2) {
#pragma unroll
        for (int j = 0; j < 4; ++j) ((f32x4*)frow)[lane + 64 * j] = v[j];
    } else {
#pragma unroll
        for (int j = 0; j < 4; ++j) { v2u o; o.x = pk2(v[j].x, v[j].y); o.y = pk2(v[j].z, v[j].w); ((v2u*)orow)[lane + 64 * j] = o; }
    }
    if (MODE == 1) {
        float ga[8];
#pragma unroll
        for (int i = 0; i < 8; ++i) ga[i] = 0.f;
#pragma unroll
        for (int j = 0; j < 4; ++j)
#pragma unroll
            for (int e = 0; e < 4; ++e) { const int k = 4 * lane + 256 * j + e; const f32x4 a = *(const LAS f32x4*)(Wg + k * 8), b = *(const LAS f32x4*)(Wg + k * 8 + 4); const float x = v[j][e];
                ga[0] += x * a.x; ga[1] += x * a.y; ga[2] += x * a.z; ga[3] += x * a.w; ga[4] += x * b.x; ga[5] += x * b.y; ga[6] += x * b.z; ga[7] += x * b.w; }
#pragma unroll
        for (int i = 0; i < 8; ++i) ga[i] = wave_sum(ga[i]);
        if (lane == 0) {
            f32x4 o0 = {ga[0] + bias[0], ga[1] + bias[1], ga[2] + bias[2], ga[3] + bias[3]}, o1 = {ga[4] + bias[4], ga[5] + bias[5], ga[6] + bias[6], ga[7] + bias[7]};
            ((f32x4*)grow)[0] = o0; ((f32x4*)grow)[1] = o1; }
    }
}

template <int MODE>
__device__ __forceinline__ void norm_row_pair(const float* x0, const float* x1, const float* gain, bf16* o0, bf16* o1, float* f0, float* f1, int lane) {
    const f32x4* xa = (const f32x4*)x0 + lane; const f32x4* xb = (const f32x4*)x1 + lane; const f32x4* gr = (const f32x4*)gain + lane;
    f32x4 v[4], w[4], g[4]; float sa = 0.f, sb = 0.f;
#pragma unroll
    for (int j = 0; j < 4; ++j) { v[j] = xa[64 * j]; w[j] = xb[64 * j]; g[j] = gr[64 * j]; }
#pragma unroll
    for (int j = 0; j < 4; ++j) { sa += (v[j].x * v[j].x + v[j].y * v[j].y) + (v[j].z * v[j].z + v[j].w * v[j].w); sb += (w[j].x * w[j].x + w[j].y * w[j].y) + (w[j].z * w[j].z + w[j].w * w[j].w); }
    const float ra = __builtin_amdgcn_rsqf(wave_sum(sa) * (1.0f / DM) + EPS), rb = __builtin_amdgcn_rsqf(wave_sum(sb) * (1.0f / DM) + EPS);
#pragma unroll
    for (int j = 0; j < 4; ++j) { v[j] = v[j] * ra * g[j]; w[j] = w[j] * rb * g[j]; }
    if (MODE == 2) {
#pragma unroll
        for (int j = 0; j < 4; ++j) { ((f32x4*)f0)[lane + 64 * j] = v[j]; ((f32x4*)f1)[lane + 64 * j] = w[j]; }
    } else {
#pragma unroll
        for (int j = 0; j < 4; ++j) { v2u a; a.x = pk2(v[j].x, v[j].y); a.y = pk2(v[j].z, v[j].w); ((v2u*)o0)[lane + 64 * j] = a; v2u b; b.x = pk2(w[j].x, w[j].y); b.y = pk2(w[j].z, w[j].w); ((v2u*)o1)[lane + 64 * j] = b; }
    }
}

__global__ void __launch_bounds__(512, 2) mega(Args args) {
    extern __shared__ __attribute__((aligned(16))) unsigned char lds[];
    cg::grid_group grid = cg::this_grid();
    typedef const Args __attribute__((address_space(4))) CArgs;
#define PH_INIT \
    CArgs* ap = (CArgs*)__builtin_amdgcn_kernarg_segment_ptr(); asm volatile("" : "+s"(ap)); \
    int tid = threadIdx.x; asm volatile("" : "+v"(tid)); \
    LAS unsigned char* L = (LAS unsigned char*)lds; \
    const int lane = tid & 63, wave = __builtin_amdgcn_readfirstlane(tid >> 6); \
    const int G = gridDim.x; const int bx = blockIdx.x; const int vcu = (G % 8 == 0) ? (bx % 8) * (G / 8) + bx / 8 : bx; \
    const int lr = lane & 15, lg = lane >> 4; \
    unsigned char* ws = ap->ws; float* out = ap->out; \
    float* GATES = (float*)(ws + WS_GATES); float* MLOC = (float*)(ws + WS_MLOC); float* BLAST = (float*)(ws + WS_BLAST); float* MST = (float*)(ws + WS_MST); \
    bf16* XN = (bf16*)(ws + WS_XN); bf16* YML = (bf16*)(ws + WS_YML); \
    bf16* ST = (bf16*)(ws + WS_ST); float* DN = (float*)(ws + WS_DN); \
    const size_t TS = (size_t)M * 1024; \
    bf16* PA = (bf16*)(ws + WS_PA); bf16* P2 = (bf16*)(ws + WS_P2); \
    (void)lane; (void)wave; (void)vcu; (void)lr; (void)lg; (void)out; (void)GATES; (void)MLOC; (void)BLAST; (void)MST; (void)XN; (void)YML; (void)ST; (void)DN; (void)TS; (void)PA; (void)P2; (void)L; (void)bx;
    { int t0 = threadIdx.x; if (t0 < 32) ((LAS unsigned*)((LAS unsigned char*)lds + MISC_OFF))[t0] = 0u; }
    __syncthreads();
    { CArgs* apb = (CArgs*)__builtin_amdgcn_kernarg_segment_ptr(); (void)xcd_barrier_post((unsigned*)apb->ws, (volatile LAS unsigned*)((LAS unsigned char*)lds + MISC_OFF) + 8); }
    int ph_lo, ph_hi;
    { CArgs* ap0 = (CArgs*)__builtin_amdgcn_kernarg_segment_ptr(); ph_lo = ap0->ph_lo; ph_hi = ap0->ph_hi; }

    for (int p = ph_lo; p < ph_hi; ++p) {
        if (p > ph_lo) {
            if (ph_hi < 0) grid.sync();
            { CArgs* apb = (CArgs*)__builtin_amdgcn_kernarg_segment_ptr(); XcdBarrier xbr; xbr.bar = (unsigned*)apb->ws; xbr.x = xb_xcc_id(); xbr.st = (volatile LAS unsigned*)((LAS unsigned char*)lds + MISC_OFF) + 8; xcd_barrier(xbr); }
        }
        const int l = p / NPH, k = (p == 2 * NPH) ? NPH : p % NPH;
        const int nrep = ((DUP_MASK >> k) & 1) ? 2 : 1;
        for (int rep = 0; rep < nrep; ++rep) { const bool dry = rep + 1 < nrep; (void)dry;
        switch (k) {
        case 0: { if (!((PHMASK >> 0) & 1)) break; PH_INIT
            LAS float* scr = (LAS float*)(L + wave * 8704);
            const int gw = vcu * 8 + wave, NGW = G * 8;
            const float* win = ap->in[2] + (size_t)l * 1024 * NIN;
            for (int it = gw; it < 12800; it += NGW) {
                if (it < 6656) { const int grp = it >> 9, r = it & 511;
                    const int coff = grp < 4 ? grp * 1024 : (grp == 4 ? 7176 : (grp < 8 ? 4104 + (grp - 5) * 1024 : (grp < 10 ? 8200 + (grp - 8) * 1024 : (grp == 10 ? 11272 : (grp == 11 ? 10248 : 12296)))));
                    transpose_item(win + coff, NIN, 1024, 1024, (bf16*)(ws + WS_WIN), grp * 1024, scr, r, lane); }
                else if (it < 8704) { const int mi = (it - 6656) >> 9, r = (it - 6656) & 511;
                    transpose_item(ap->in[mi == 0 ? 7 : (mi == 1 ? 6 : 6 + mi)] + (size_t)l * 1024 * 1024, 1024, 1024, 1024, (bf16*)(ws + WS_WML + (size_t)mi * 2 * MiB), 0, scr, r, lane); }
                else if (it < 10752) transpose_item(ap->in[11] + (size_t)l * 1024 * FF, FF, FF, 1024, (bf16*)(ws + WS_WUP), 0, scr, it - 8704, lane);
                else transpose_item(ap->in[12] + (size_t)l * FF * 1024, 1024, 1024, FF, (bf16*)(ws + WS_WDN), 0, scr, it - 10752, lane);
            }
            LAS float* Wg = (LAS float*)(L + 73728);
            for (int i = tid; i < 8192; i += 512) Wg[i] = win[(size_t)(i >> 3) * NIN + 4096 + (i & 7)];
            __syncthreads();
            const float* xsrc = l == 0 ? ap->in[0] : out;
            for (int m = gw; m < M; m += NGW)
                norm_row<1>(xsrc + (size_t)m * DM, ap->in[1] + l * DM, XN + (size_t)m * DM, nullptr, Wg, ap->in[3] + l * 8, GATES + (size_t)m * 8, lane);
            __syncthreads();
        } break;
        case 1: case 5: case 10: {
            if (!((PHMASK >> k) & 1)) break; PH_INIT
            const bf16* Bt = k == 1 ? (const bf16*)(ws + WS_WIN) : (k == 5 ? (const bf16*)(ws + WS_WIN) + (size_t)4096 * 1024 : (const bf16*)(ws + WS_WUP));
            const int N = k == 1 ? 4096 : (k == 5 ? 9216 : FF);
            pg8::Gemm g{XN, Bt, M, N, 1024}; pg8::StaticOrder S; S.init(M, N, G, bx);
            pg8::EpiStore E{k == 10 ? (bf16*)(ws + WS_HB) : PA, k == 10 ? FF : 1024, k == 10 ? 0 : 1024, TS, k == 1 ? 0 : (k == 5 ? 1 : 2), 6, k == 5 ? 5 : -1};
            pg8::gemm_phase<pg8::EpiStore, pg8::StaticOrder, true, true>((PG8_LAS unsigned char*)L, g, S, E);
        } break;
        case 8: {
            if (!((PHMASK >> k) & 1)) break; PH_INIT
            pg8::Gemm g{(const bf16*)(ws + WS_MGB), (const bf16*)(ws + WS_WOUT), M, 1024, 1024}; pg8::StaticOrder S; S.init(M, 1024, G, bx);
            pg8::EpiRes E{l == 0 ? ap->in[0] : out, out};
            pg8::gemm_phase<pg8::EpiRes, pg8::StaticOrder, true, true>((PG8_LAS unsigned char*)L, g, S, E);
        } break;
        case 11: {
            if (!((PHMASK >> k) & 1)) break; PH_INIT
            pg8::Gemm g{(const bf16*)(ws + WS_HB), (const bf16*)(ws + WS_WDN), M, 1024, FF}; pg8::StaticOrder S; S.init(M, 1024, G, bx);
            pg8::EpiRes E{out, out};
            pg8::gemm_phase<pg8::EpiRes, pg8::StaticOrder, true, true>((PG8_LAS unsigned char*)L, g, S, E);
        } break;
        case 2: { if (!((PHMASK >> 2) & 1)) break; PH_INIT
            LAS bf16* KT = (LAS bf16*)L; LAS bf16* VT = (LAS bf16*)(L + 36864); LAS float* wS = (LAS float*)(L + 73728);
            for (int u = vcu; u < 1024; u += G) {
                const int bh = u >> 7, c = u & 127, b = bh >> 2, h = bh & 3; const size_t r0 = (size_t)b * SEQ + c * 64;
                v4u kq[2][2], vq[2][2];
#pragma unroll
                for (int i = 0; i < 2; ++i) { const int it = tid + 512 * i, d8 = it >> 5, sp = it & 31; const size_t go = (r0 + 2 * sp) * 1024 + h * 256 + d8 * 8;
                    kq[i][0] = *(const v4u*)(PA + TS + go); kq[i][1] = *(const v4u*)(PA + TS + go + 1024); vq[i][0] = *(const v4u*)(PA + 2 * TS + go); vq[i][1] = *(const v4u*)(PA + 2 * TS + go + 1024); }
                {
                    const float ip = GATES[(r0 + lane) * 8 + h], fp = GATES[(r0 + lane) * 8 + 4 + h];
                    const float bc = wave_prefix(log_sigmoid(fp), lane); const float blast = __shfl(bc, 63);
                    const float gg = blast - bc + ip; const float mloc = wave_max(gg);
                    wS[lane] = __expf(gg - mloc);
                    if (wave == 0 && lane == 0) { MLOC[u] = mloc; BLAST[u] = blast; }
                }
                __syncthreads();
#pragma unroll
                for (int i = 0; i < 2; ++i) { const int it = tid + 512 * i, d8 = it >> 5, sp = it & 31; const float w0 = wS[2 * sp], w1 = wS[2 * sp + 1];
                    LAS unsigned* kt = (LAS unsigned*)(KT + (d8 * 8) * 72 + 2 * sp); LAS unsigned* vt = (LAS unsigned*)(VT + (d8 * 8) * 72 + 2 * sp);
#define KV4(F, J) kt[(J) * 36] = pk2(bflo(kq[i][0].F) * 0.0625f, bflo(kq[i][1].F) * 0.0625f); kt[(J + 1) * 36] = pk2(bfhi(kq[i][0].F) * 0.0625f, bfhi(kq[i][1].F) * 0.0625f); \
                    vt[(J) * 36] = pk2(bflo(vq[i][0].F) * w0, bflo(vq[i][1].F) * w1); vt[(J + 1) * 36] = pk2(bfhi(vq[i][0].F) * w0, bfhi(vq[i][1].F) * w1);
                    KV4(x, 0) KV4(y, 2) KV4(z, 4) KV4(w, 6)
#undef KV4
                }
                __syncthreads();
                if (tid < 256) { float a = 0.f;
#pragma unroll 8
                    for (int s = 0; s < 64; ++s) a += wS[s] * bf2f(KT[tid * 72 + s]);
                    DN[(size_t)u * 256 + tid] = a; }
                bf16* Cg = ST + (size_t)u * 65536;
                {
                    const int krow = wave * 32 + 8 * (lr >> 2) + (lr & 3);
                    const bf16x8 a00 = *(const LAS bf16x8*)(KT + krow * 72 + 8 * lg), a01 = *(const LAS bf16x8*)(KT + krow * 72 + 32 + 8 * lg);
                    const bf16x8 a10 = *(const LAS bf16x8*)(KT + (krow + 4) * 72 + 8 * lg), a11 = *(const LAS bf16x8*)(KT + (krow + 4) * 72 + 32 + 8 * lg);
#pragma unroll 4
                    for (int nb = 0; nb < 16; ++nb) {
                        const bf16x8 b0 = *(const LAS bf16x8*)(VT + (nb * 16 + lr) * 72 + 8 * lg), b1 = *(const LAS bf16x8*)(VT + (nb * 16 + lr) * 72 + 32 + 8 * lg);
                        f32x4 c0 = {0.f, 0.f, 0.f, 0.f}, c1 = {0.f, 0.f, 0.f, 0.f};
                        c0 = __builtin_amdgcn_mfma_f32_16x16x32_bf16(a00, b0, c0, 0, 0, 0); c1 = __builtin_amdgcn_mfma_f32_16x16x32_bf16(a10, b0, c1, 0, 0, 0);
                        c0 = __builtin_amdgcn_mfma_f32_16x16x32_bf16(a01, b1, c0, 0, 0, 0); c1 = __builtin_amdgcn_mfma_f32_16x16x32_bf16(a11, b1, c1, 0, 0, 0);
                        v4u o; o.x = pk2(c0[0], c0[1]); o.y = pk2(c0[2], c0[3]); o.z = pk2(c1[0], c1[1]); o.w = pk2(c1[2], c1[3]);
                        *(v4u*)(Cg + (size_t)(nb * 16 + lr) * 256 + wave * 32 + 8 * lg) = o; }
                }
                __syncthreads();
            }
        } break;
        case 3: { if (!((PHMASK >> 3) & 1)) break; PH_INIT
            LAS float* sA = (LAS float*)L; LAS float* sB = sA + 128; LAS float* sML = sA + 256; LAS float* sBL = sA + 384; LAS float* sM = sA + 512;
            for (int q0 = vcu * 512; q0 < 131072; q0 += G * 512) {
                const int chain = q0 >> 14, eb = q0 & 16383, e4 = eb + tid;
                if (tid < 128) { sML[tid] = MLOC[chain * 128 + tid]; sBL[tid] = BLAST[chain * 128 + tid]; }
                __syncthreads();
                if (tid == 0) { float m = 0.f;
                    for (int c = 0; c < 128; ++c) { sM[c] = m; m = fmaxf(sBL[c] + m, sML[c]); } sM[128] = m; }
                __syncthreads();
                if (tid < 128) { const float m0 = sM[tid], m1 = sM[tid + 1]; sA[tid] = __expf(sBL[tid] + m0 - m1); sB[tid] = __expf(sML[tid] - m1); if (eb == 0 && !dry) MST[chain * 128 + tid] = m0; }
                __syncthreads();
                {
                    unsigned long long* pp = (unsigned long long*)ST + (size_t)chain * 128 * 16384 + e4;
                    float C0 = 0.f, C1 = 0.f, C2 = 0.f, C3 = 0.f;
                    unsigned long long cur[16], nxt[16];
#pragma unroll
                    for (int j = 0; j < 16; ++j) cur[j] = pp[(size_t)j * 16384];
                    for (int c = 0; c < 128; c += 16) {
#pragma unroll
                        for (int j = 0; j < 16; ++j) { const int cn = (c + 16 + j < 128) ? c + 16 + j : 127; nxt[j] = pp[(size_t)cn * 16384]; }
#pragma unroll
                        for (int j = 0; j < 16; ++j) { const float a = sA[c + j], bs = sB[c + j];
                            const unsigned lo = pk2(C0, C1), hi = pk2(C2, C3);
                            if (!dry) pp[(size_t)(c + j) * 16384] = (unsigned long long)lo | ((unsigned long long)hi << 32);
                            const unsigned dlo = (unsigned)cur[j], dhi = (unsigned)(cur[j] >> 32);
                            C0 = a * C0 + bs * bflo(dlo); C1 = a * C1 + bs * bfhi(dlo); C2 = a * C2 + bs * bflo(dhi); C3 = a * C3 + bs * bfhi(dhi); }
#pragma unroll
                        for (int j = 0; j < 16; ++j) cur[j] = nxt[j];
                    }
                }
                if (tid < 8) {
                    float* pn = DN + (size_t)chain * 128 * 256 + (eb >> 9) * 8 + tid; float n = 0.f;
                    for (int c = 0; c < 128; c += 16) { float d[16];
#pragma unroll
                        for (int j = 0; j < 16; ++j) d[j] = pn[(size_t)(c + j) * 256];
#pragma unroll
                        for (int j = 0; j < 16; ++j) { if (!dry) pn[(size_t)(c + j) * 256] = n; n = sA[c + j] * n + sB[c + j] * d[j]; } }
                }
                __syncthreads();
            }
        } break;
        case 4: { if (!((PHMASK >> 4) & 1)) break; PH_INIT
            LAS bf16* Qs = (LAS bf16*)L; LAS bf16* Ks = (LAS bf16*)(L + 33792); LAS float* Sf = (LAS float*)(L + 67584); LAS bf16* VT = (LAS bf16*)(L + 84224);
            LAS bf16* Wt = (LAS bf16*)(L + 43008 + wave * 5120);
            LAS bf16* Pb = Ks;
            LAS float* bcs = (LAS float*)(L + 121088); LAS float* ii = bcs + 64; LAS float* AI = bcs + 128; LAS float* DEN = bcs + 192; LAS float* SSQ = bcs + 256; LAS float* DNs = bcs + 768;
            for (int u = vcu; u < 1024; u += G) {
                int tq_ = tid; asm volatile("" : "+v"(tq_)); const int ltid = tq_, llane = ltid & 63, llr = llane & 15, llg = llane >> 4;
                const int bh = u >> 7, c = u & 127, b = bh >> 2, h = bh & 3; const size_t r0 = (size_t)b * SEQ + c * 64;
                const bf16* Cg = ST + (size_t)u * 65536;
                const float mc = MST[u];
                if (ltid < 256) DNs[ltid] = DN[(size_t)u * 256 + ltid];
                {
                    const float ip = GATES[(r0 + llane) * 8 + h], fp = GATES[(r0 + llane) * 8 + 4 + h];
                    bcs[llane] = wave_prefix(log_sigmoid(fp), llane); ii[llane] = ip;
                }
                for (int it = ltid; it < 2048; it += 512) { const int s = it >> 5, d8 = it & 31; const size_t go = (r0 + s) * 1024 + h * 256 + d8 * 8;
                    const v4u qv = *(const v4u*)(PA + go), kv = *(const v4u*)(PA + TS + go);
                    *(LAS v4u*)(Qs + s * 264 + d8 * 8) = qv;
                    v4u ks; ks.x = pk2(bflo(kv.x) * 0.0625f, bfhi(kv.x) * 0.0625f); ks.y = pk2(bflo(kv.y) * 0.0625f, bfhi(kv.y) * 0.0625f); ks.z = pk2(bflo(kv.z) * 0.0625f, bfhi(kv.z) * 0.0625f); ks.w = pk2(bflo(kv.w) * 0.0625f, bfhi(kv.w) * 0.0625f);
                    *(LAS v4u*)(Ks + s * 264 + d8 * 8) = ks; }
#pragma unroll
                for (int i = 0; i < 2; ++i) { const int it = ltid + 512 * i, d8 = it >> 5, sp = it & 31; const size_t go = (r0 + 2 * sp) * 1024 + h * 256 + d8 * 8;
                    const v4u v0 = *(const v4u*)(PA + 2 * TS + go), v1 = *(const v4u*)(PA + 2 * TS + go + 1024);
                    LAS unsigned* vt = (LAS unsigned*)(VT + (d8 * 8) * 72 + 2 * sp);
#define VP4(F, J) vt[(J) * 36] = (v0.F & 0xffffu) | (v1.F << 16); vt[(J + 1) * 36] = (v0.F >> 16) | (v1.F & 0xffff0000u);
                    VP4(x, 0) VP4(y, 2) VP4(z, 4) VP4(w, 6)
#undef VP4
                }
                bf16x8 cfr[8][2];
#pragma unroll
                for (int kk = 0; kk < 8; ++kk)
#pragma unroll
                    for (int nbi = 0; nbi < 2; ++nbi) cfr[kk][nbi] = *(const bf16x8*)(Cg + (size_t)((wave * 2 + nbi) * 16 + llr) * 256 + (kk >> 1) * 64 + 16 * llg + 8 * (kk & 1));
                __syncthreads();
                {
                    const int tb = wave >> 1;
#pragma unroll
                    for (int sbi = 0; sbi < 2; ++sbi) { const int sb = (wave & 1) * 2 + sbi; f32x4 acc = {0.f, 0.f, 0.f, 0.f};
#pragma unroll
                        for (int kk = 0; kk < 8; ++kk) { const bf16x8 a = *(const LAS bf16x8*)(Qs + (tb * 16 + llr) * 264 + kk * 32 + 8 * llg), bb = *(const LAS bf16x8*)(Ks + (sb * 16 + llr) * 264 + kk * 32 + 8 * llg);
                            acc = __builtin_amdgcn_mfma_f32_16x16x32_bf16(a, bb, acc, 0, 0, 0); }
#pragma unroll
                        for (int r = 0; r < 4; ++r) Sf[(tb * 16 + 4 * llg + r) * 65 + sb * 16 + llr] = acc[r]; }
                }
                __syncthreads();
                {
                    const int t = ltid >> 3, part = ltid & 7; const float bt = bcs[t];
                    float d[8]; float mx = -INFINITY;
#pragma unroll
                    for (int j = 0; j < 8; ++j) { const int s = part * 8 + j; d[j] = (s <= t) ? (bt - bcs[s] + ii[s]) : -INFINITY; mx = fmaxf(mx, d[j]); }
                    mx = fmaxf(mx, __shfl_xor(mx, 1)); mx = fmaxf(mx, __shfl_xor(mx, 2)); mx = fmaxf(mx, __shfl_xor(mx, 4));
                    const float inter = bt + mc, mt = fmaxf(inter, mx);
                    float rs = 0.f; unsigned pw[4];
#pragma unroll
                    for (int j = 0; j < 8; j += 2) { const int s = part * 8 + j;
                        const float p0 = (s <= t) ? Sf[t * 65 + s] * __expf(d[j] - mt) : 0.f, p1 = (s + 1 <= t) ? Sf[t * 65 + s + 1] * __expf(d[j + 1] - mt) : 0.f;
                        rs += p0 + p1; pw[j >> 1] = pk2(p0, p1); }
                    v4u pv; pv.x = pw[0]; pv.y = pw[1]; pv.z = pw[2]; pv.w = pw[3];
                    rs += __shfl_xor(rs, 1); rs += __shfl_xor(rs, 2); rs += __shfl_xor(rs, 4);
                    float dq = 0.f; const LAS float* dn = DNs + part * 32;
#pragma unroll 8
                    for (int kk = 0; kk < 32; ++kk) dq += bf2f(Qs[t * 264 + part * 32 + kk]) * dn[kk];
                    dq += __shfl_xor(dq, 1); dq += __shfl_xor(dq, 2); dq += __shfl_xor(dq, 4);
                    const float ai = __expf(inter - mt);
                    *(LAS v4u*)(Pb + t * 72 + part * 8) = pv;
                    if (part == 0) { AI[t] = ai; DEN[t] = fmaxf(fabsf(rs + ai * dq), __expf(-mt)); }
                }
                __syncthreads();
                {
                    {
                        const bf16* Og = PA + 3 * TS;
#pragma unroll
                        for (int i = 0; i < 4; ++i) { const int row = i * 16 + (llane >> 2), ch = llane & 3;
                            const v4u w = *(const v4u*)(Og + (r0 + row) * 1024 + h * 256 + wave * 32 + ch * 8); *(LAS v4u*)(Wt + row * 40 + ch * 8) = w; }
                    }
                    f32x4 acc[4][2];
#pragma unroll
                    for (int tb = 0; tb < 4; ++tb) { acc[tb][0] = (f32x4){0.f, 0.f, 0.f, 0.f}; acc[tb][1] = (f32x4){0.f, 0.f, 0.f, 0.f}; }
#pragma unroll
                    for (int kk = 0; kk < 8; ++kk) {
                        bf16x8 bfr[2]; bfr[0] = cfr[kk][0]; bfr[1] = cfr[kk][1];
#pragma unroll
                        for (int tb = 0; tb < 4; ++tb) { const bf16x8 a = *(const LAS bf16x8*)(Qs + (tb * 16 + llr) * 264 + (kk >> 1) * 64 + 16 * llg + 8 * (kk & 1));
                            acc[tb][0] = __builtin_amdgcn_mfma_f32_16x16x32_bf16(a, bfr[0], acc[tb][0], 0, 0, 0);
                            acc[tb][1] = __builtin_amdgcn_mfma_f32_16x16x32_bf16(a, bfr[1], acc[tb][1], 0, 0, 0); }
                    }
#pragma unroll
                    for (int tb = 0; tb < 4; ++tb)
#pragma unroll
                        for (int r = 0; r < 4; ++r) { const float ai = AI[tb * 16 + 4 * llg + r]; acc[tb][0][r] *= ai; acc[tb][1][r] *= ai; }
#pragma unroll
                    for (int kk = 0; kk < 2; ++kk) {
                        bf16x8 bfr[2];
#pragma unroll
                        for (int nbi = 0; nbi < 2; ++nbi) bfr[nbi] = *(const LAS bf16x8*)(VT + ((wave * 2 + nbi) * 16 + llr) * 72 + kk * 32 + 8 * llg);
#pragma unroll
                        for (int tb = 0; tb < 4; ++tb) { const bf16x8 a = *(const LAS bf16x8*)(Pb + (tb * 16 + llr) * 72 + kk * 32 + 8 * llg);
                            acc[tb][0] = __builtin_amdgcn_mfma_f32_16x16x32_bf16(a, bfr[0], acc[tb][0], 0, 0, 0);
                            acc[tb][1] = __builtin_amdgcn_mfma_f32_16x16x32_bf16(a, bfr[1], acc[tb][1], 0, 0, 0); }
                    }
                    asm volatile("s_waitcnt lgkmcnt(0)" ::: "memory");
#pragma unroll
                    for (int tb = 0; tb < 4; ++tb)
#pragma unroll
                        for (int r = 0; r < 4; ++r) { const int t = tb * 16 + 4 * llg + r; const float inv = __builtin_amdgcn_rcpf(DEN[t]); float sq = 0.f;
#pragma unroll
                            for (int nbi = 0; nbi < 2; ++nbi) { const float og = bf2f(Wt[t * 40 + nbi * 16 + llr]);
                                const float y = acc[tb][nbi][r] * inv * __builtin_amdgcn_rcpf(1.0f + __expf(-og)); acc[tb][nbi][r] = y; sq += y * y; }
                            sq += __shfl_xor(sq, 1); sq += __shfl_xor(sq, 2); sq += __shfl_xor(sq, 4); sq += __shfl_xor(sq, 8);
                            if (llr == 0) SSQ[wave * 64 + t] = sq; }
                    __syncthreads();
                    const float* gn = ap->in[4] + l * 1024 + h * 256;
                    const float g0 = gn[wave * 32 + llr], g1 = gn[wave * 32 + 16 + llr];
#pragma unroll
                    for (int tb = 0; tb < 4; ++tb)
#pragma unroll
                        for (int r = 0; r < 4; ++r) { const int t = tb * 16 + 4 * llg + r; float tot = 0.f;
#pragma unroll
                            for (int w = 0; w < 8; ++w) tot += SSQ[w * 64 + t];
                            const float rstd = __builtin_amdgcn_rsqf(tot * (1.0f / 256.0f) + EPS);
                            Wt[t * 40 + llr] = f2bf(acc[tb][0][r] * rstd * g0); Wt[t * 40 + 16 + llr] = f2bf(acc[tb][1][r] * rstd * g1); }
                    asm volatile("s_waitcnt lgkmcnt(0)" ::: "memory");
#pragma unroll
                    for (int i = 0; i < 4; ++i) { const int row = i * 16 + (llane >> 2), ch = llane & 3;
                        *(v4u*)(YML + (r0 + row) * 1024 + h * 256 + wave * 32 + ch * 8) = *(const LAS v4u*)(Wt + row * 40 + ch * 8); }
                }
                __syncthreads();
            }
        } break;
        case 6: { if (!((PHMASK >> 6) & 1)) break; PH_INIT
            {
                if (tid == 0) *(LAS unsigned*)L = 0u;
                __syncthreads();
                const bf16* SCB = P2 + TS; const bf16* SCC = P2 + 2 * TS; const bf16* SCU = P2 + 3 * TS; bf16* YSC = (bf16*)(ws + WS_YSC);
                const float* cw = ap->in[5] + (size_t)l * 3 * 1024;
                if (wave < 4) for (int it = vcu * 256 + tid; it < M * 128; it += G * 256) { const int row = it >> 7, c8 = it & 127, t = row & (SEQ - 1); const size_t o = (size_t)row * 1024 + c8 * 8;
                    const v4u bv = *(const v4u*)(SCB + o), c0 = *(const v4u*)(SCC + o), u0 = *(const v4u*)(SCU + o);
                    v4u c1 = {0u, 0u, 0u, 0u}, u1 = c1, c2 = c1, u2 = c1;
                    if (t >= 1) { c1 = *(const v4u*)(SCC + o - 1024); u1 = *(const v4u*)(SCU + o - 1024); }
                    if (t >= 2) { c2 = *(const v4u*)(SCC + o - 2048); u2 = *(const v4u*)(SCU + o - 2048); }
                    const f32x4 w0a = *(const f32x4*)(cw + c8 * 8), w0b = *(const f32x4*)(cw + c8 * 8 + 4), w1a = *(const f32x4*)(cw + 1024 + c8 * 8), w1b = *(const f32x4*)(cw + 1024 + c8 * 8 + 4),
                                w2a = *(const f32x4*)(cw + 2048 + c8 * 8), w2b = *(const f32x4*)(cw + 2048 + c8 * 8 + 4);
                    v4u ov;
#define CONV2(F, WA, E0, E1) pk2(bflo(bv.F) * (WA##0[E0] * bflo(c2.F) * bflo(u2.F) + WA##1[E0] * bflo(c1.F) * bflo(u1.F) + WA##2[E0] * bflo(c0.F) * bflo(u0.F)), \
                                 bfhi(bv.F) * (WA##0[E1] * bfhi(c2.F) * bfhi(u2.F) + WA##1[E1] * bfhi(c1.F) * bfhi(u1.F) + WA##2[E1] * bfhi(c0.F) * bfhi(u0.F)))
                    const f32x4 wa0 = w0a, wa1 = w1a, wa2 = w2a, wb0 = w0b, wb1 = w1b, wb2 = w2b;
                    ov.x = CONV2(x, wa, 0, 1); ov.y = CONV2(y, wa, 2, 3); ov.z = CONV2(z, wb, 0, 1); ov.w = CONV2(w, wb, 2, 3);
#undef CONV2
                    *(v4u*)(YSC + o) = ov; }
            }
            {
                bf16* SBQ = P2; const bf16* SBK = P2 + 4 * TS; const bf16* VTg = P2 + 5 * TS;
                const int nU = (8192 - vcu + G - 1) / G;
                for (;;) { int j = 0; if (lane == 0) j = (int)__hip_atomic_fetch_add((LAS unsigned*)L, 1u, __ATOMIC_RELAXED, __HIP_MEMORY_SCOPE_WORKGROUP);
                    j = __builtin_amdgcn_readfirstlane(j); if (j >= nU) break; const int wu = vcu + G * j;
                    __builtin_amdgcn_s_setprio(2);
                    const int bh = wu >> 8, qt = wu & 255, b = bh >> 4, h = bh & 15, q0 = qt * 32;
                    bf16x8 qf[2][2];
#pragma unroll
                    for (int qb = 0; qb < 2; ++qb)
#pragma unroll
                        for (int kk = 0; kk < 2; ++kk) qf[qb][kk] = *(const bf16x8*)(SBQ + ((size_t)b * SEQ + q0 + qb * 16 + lr) * 1024 + h * 64 + kk * 32 + 8 * lg);
                    f32x4 o[2][4];
#pragma unroll
                    for (int qb = 0; qb < 2; ++qb)
#pragma unroll
                        for (int db = 0; db < 4; ++db) o[qb][db] = (f32x4){0.f, 0.f, 0.f, 0.f};
                    float R[2] = {0.f, 0.f};
                    const bf16* Kb = SBK + (size_t)b * SEQ * 1024 + h * 64 + 8 * lg;
                    const bf16* Vb = VTg + (size_t)(b * 1024 + h * 64 + lr) * SEQ + 4 * lg;
                    bf16x8 kfr[4][2];
                    { const int kt0 = (q0 >> 6) << 6;
#pragma unroll
                      for (int kb = 0; kb < 4; ++kb) { const bf16* kp = Kb + (size_t)(kt0 + kb * 16 + lr) * 1024; kfr[kb][0] = *(const bf16x8*)kp; kfr[kb][1] = *(const bf16x8*)(kp + 32); } }
                    for (int kt = (q0 >> 6) << 6; kt >= 0; kt -= 64) {
                        v2u vlo[2][4], vhi[2][4];
#pragma unroll
                        for (int kk2 = 0; kk2 < 2; ++kk2)
#pragma unroll
                            for (int db = 0; db < 4; ++db) { const bf16* vp = Vb + (size_t)(db * 16) * SEQ + kt + kk2 * 32; vlo[kk2][db] = *(const v2u*)vp; vhi[kk2][db] = *(const v2u*)(vp + 16); }
                        bf16x8 knx[4][2];
                        { const int ktn = kt >= 64 ? kt - 64 : 0;
#pragma unroll
                          for (int kb = 0; kb < 4; ++kb) { const bf16* kp = Kb + (size_t)(ktn + kb * 16 + lr) * 1024; knx[kb][0] = *(const bf16x8*)kp; knx[kb][1] = *(const bf16x8*)(kp + 32); } }
                        f32x4 st[4][2];
#pragma unroll
                        for (int kb = 0; kb < 4; ++kb) {
#pragma unroll
                            for (int qb = 0; qb < 2; ++qb) { f32x4 z4 = {0.f, 0.f, 0.f, 0.f};
                                z4 = __builtin_amdgcn_mfma_f32_16x16x32_bf16(kfr[kb][0], qf[qb][0], z4, 0, 0, 0);
                                st[kb][qb] = __builtin_amdgcn_mfma_f32_16x16x32_bf16(kfr[kb][1], qf[qb][1], z4, 0, 0, 0); } }
                        unsigned pp[2][4][2];
#pragma unroll
                        for (int qb = 0; qb < 2; ++qb) { const int tq = q0 + qb * 16 + lr;
                            float lpv[4][4], lbv[4][4], Hs[4], tot[4];
#pragma unroll
                            for (int kb = 0; kb < 4; ++kb) { float gs = 0.f;
                                if (kt + kb * 16 >= q0 + qb * 16 + 16) {
#pragma unroll
                                    for (int r = 0; r < 4; ++r) { lpv[kb][r] = 0.f; lbv[kb][r] = -INFINITY; }
                                } else {
#pragma unroll
                                for (int r = 0; r < 4; ++r) { const int key = kt + kb * 16 + 4 * lg + r; const float z = st[kb][qb][r] * (0.125f * 1.4426950408889634f);
                                    const float sp = fmaxf(z, 0.f) + __builtin_amdgcn_logf(1.0f + __builtin_amdgcn_exp2f(-fabsf(z)));
                                    const bool act = key < tq; lpv[kb][r] = act ? -sp : 0.f; lbv[kb][r] = act ? z - sp : -INFINITY; gs += lpv[kb][r]; }
                                }
                                const unsigned gu = __float_as_uint(gs);
                                const auto r16 = __builtin_amdgcn_permlane16_swap(gu, gu, false, false);
                                const float e0 = __uint_as_float(r16[0]), e1 = __uint_as_float(r16[1]);
                                const float pp1 = (lg & 1) ? e0 : e1, s2 = e0 + e1;
                                const unsigned su = __float_as_uint(s2);
                                const auto r32 = __builtin_amdgcn_permlane32_swap(su, su, false, false);
                                const float qq = (lg & 2) ? __uint_as_float(r32[0]) : __uint_as_float(r32[1]);
                                tot[kb] = s2 + qq;
                                Hs[kb] = ((lg & 1) ? 0.f : pp1) + ((lg & 2) ? 0.f : qq); }
                            float base = R[qb];
#pragma unroll
                            for (int kb = 3; kb >= 0; --kb) { float acc = base + Hs[kb]; float pa[4];
#pragma unroll
                                for (int r = 3; r >= 0; --r) { pa[r] = __builtin_amdgcn_exp2f(lbv[kb][r] + acc); acc += lpv[kb][r]; }
                                pp[qb][kb][0] = pk2(pa[0], pa[1]); pp[qb][kb][1] = pk2(pa[2], pa[3]); base += tot[kb]; }
                            R[qb] = base; }
#pragma unroll
                        for (int kk2 = 0; kk2 < 2; ++kk2) {
                            bf16x8 af[2];
#pragma unroll
                            for (int qb = 0; qb < 2; ++qb) { v4u t4; t4.x = pp[qb][2 * kk2][0]; t4.y = pp[qb][2 * kk2][1]; t4.z = pp[qb][2 * kk2 + 1][0]; t4.w = pp[qb][2 * kk2 + 1][1]; af[qb] = __builtin_bit_cast(bf16x8, t4); }
#pragma unroll
                            for (int db = 0; db < 4; ++db) { const v2u lo = vlo[kk2][db], hi = vhi[kk2][db];
                                v4u t4; t4.x = lo.x; t4.y = lo.y; t4.z = hi.x; t4.w = hi.y; const bf16x8 vb = __builtin_bit_cast(bf16x8, t4);
#pragma unroll
                                for (int qb = 0; qb < 2; ++qb) o[qb][db] = __builtin_amdgcn_mfma_f32_16x16x32_bf16(af[qb], vb, o[qb][db], 0, 0, 0); } }
                        if (__all(R[0] < SB_THR * 1.4426950408889634f && R[1] < SB_THR * 1.4426950408889634f)) break;
#pragma unroll
                        for (int kb = 0; kb < 4; ++kb) { kfr[kb][0] = knx[kb][0]; kfr[kb][1] = knx[kb][1]; }
                    }
                    __builtin_amdgcn_s_setprio(0);
                    if (!dry) {
#pragma unroll
                        for (int qb = 0; qb < 2; ++qb)
#pragma unroll
                            for (int db = 0; db < 4; ++db)
#pragma unroll
                                for (int r = 0; r < 4; ++r) SBQ[((size_t)b * SEQ + q0 + qb * 16 + 4 * lg + r) * 1024 + h * 64 + db * 16 + lr] = f2bf(o[qb][db][r]);
                    }
                }
            }
        } break;
        case 7: { if (!((PHMASK >> 7) & 1)) break; PH_INIT
            pg8::Gemm g{(const bf16*)(ws + WS_XN), (const bf16*)(ws + WS_WML), 3 * M, 3072, 1024}; pg8::GateSched S; S.base.init(M, 1024, G, bx);
            pg8::EpiGate E{P2 + (size_t)6 * TS, (float*)(ws + WS_MG), (bf16*)(ws + WS_MGB), TS};
            pg8::gemm_phase<pg8::EpiGate, pg8::GateSched, true, true>((PG8_LAS unsigned char*)L, g, S, E);
        } break;
        case 9: { if (!((PHMASK >> 9) & 1)) break; PH_INIT
            const int gw = vcu * 8 + wave, NGW = G * 8;
            for (int m = gw; m < M; m += 2 * NGW) { const int m1 = m + NGW;
                if (m1 < M) norm_row_pair<0>(out + (size_t)m * DM, out + (size_t)m1 * DM, ap->in[10] + l * DM, XN + (size_t)m * DM, XN + (size_t)m1 * DM, nullptr, nullptr, lane);
                else norm_row<0>(out + (size_t)m * DM, ap->in[10] + l * DM, XN + (size_t)m * DM, nullptr, nullptr, nullptr, nullptr, lane); }
        } break;
        default: { if (!((PHMASK >> 12) & 1)) break; PH_INIT
            const int gw = vcu * 8 + wave, NGW = G * 8;
            for (int m = gw; m < M; m += 2 * NGW) { const int m1 = m + NGW;
                if (m1 < M) norm_row_pair<2>(out + (size_t)m * DM, out + (size_t)m1 * DM, ap->in[13], nullptr, nullptr, out + (size_t)m * DM, out + (size_t)m1 * DM, lane);
                else norm_row<2>(out + (size_t)m * DM, ap->in[13], nullptr, out + (size_t)m * DM, nullptr, nullptr, nullptr, lane); }
        } break;
        }
        }
    }
}

#ifndef MK_PER_PHASE
#define MK_PER_PHASE 0
#endif
extern "C" void kernel_launch(void* const* d_in, const int* in_sizes, int n_in, void* d_out, int out_size, void* d_ws, size_t ws_size, hipStream_t stream) {
    static int grid = 0;
    if (grid == 0) {
        if (n_in != 14 || out_size != M * DM || ws_size < WS_END) { fprintf(stderr, "kernel_launch: unexpected shapes (n_in %d, out %d, ws %zu)\n", n_in, out_size, ws_size); grid = -1; return; }
        int dev = 0, cus = 0, per_cu = 0;
        hipGetDevice(&dev); hipDeviceGetAttribute(&cus, hipDeviceAttributeMultiprocessorCount, dev);
        if (hipFuncSetAttribute((const void*)mega, hipFuncAttributeMaxDynamicSharedMemorySize, LDS_BYTES) != hipSuccess) { fprintf(stderr, "kernel_launch: hipFuncSetAttribute failed\n"); grid = -1; return; }
        if (hipOccupancyMaxActiveBlocksPerMultiprocessor(&per_cu, (const void*)mega, 512, LDS_BYTES) != hipSuccess || per_cu < 1) { fprintf(stderr, "kernel_launch: occupancy query gave %d\n", per_cu); per_cu = 1; }
        (void)hipGetLastError();
        grid = cus * 1;
        fprintf(stderr, "kernel_launch: cus %d per_cu %d grid %d\n", cus, per_cu, grid);
    }
    if (grid < 0) return;
    if (hipMemsetAsync(d_ws, 0, 16384, stream) != hipSuccess) { fprintf(stderr, "kernel_launch: memset of the barrier words failed\n"); return; }
    Args a{};
    for (int i = 0; i < 14; ++i) a.in[i] = (const float*)d_in[i];
    a.out = (float*)d_out; a.ws = (unsigned char*)d_ws;
#if MK_PER_PHASE
    for (int p = 0; p < 2 * NPH + 1; ++p) { a.ph_lo = p; a.ph_hi = p + 1; hipLaunchKernelGGL(mega, dim3(grid), dim3(512), LDS_BYTES, stream, a); }
#else
    a.ph_lo = 0; a.ph_hi = 2 * NPH + 1;
    void* kargs[] = {&a};
    hipError_t e = hipLaunchCooperativeKernel((const void*)mega, dim3(grid), dim3(512), kargs, LDS_BYTES, stream);
    if (e != hipSuccess) fprintf(stderr, "kernel_launch: cooperative launch failed: %s (grid %d)\n", hipGetErrorString(e), grid);
#endif
}
```

```cpp
#include <hip/hip_runtime.h>
#include <hip/hip_cooperative_groups.h>
#include <cstdio>
#include <cstdint>
namespace cg = cooperative_groups;
namespace pg8 {
#define PG8_LAS __attribute__((address_space(3)))
typedef unsigned short bf16_t;
typedef short bf16x8 __attribute__((ext_vector_type(8)));
typedef float f32x4 __attribute__((ext_vector_type(4)));
typedef unsigned u32x4 __attribute__((ext_vector_type(4)));
constexpr int BM = 256, BK = 64, HALF = 128, HTB = HALF * BK * 2  , STAGE_BYTES = 8 * HTB, NXCD = 8, WGM = 4;

__host__ __device__ __forceinline__ int lds_byte(int r, int c) { const int st = (r >> 4) * 2 + (c >> 5), rr = r & 15, cc = c & 31, ob = rr * 64 + cc * 2; return st * 1024 + (ob ^ (((ob >> 9) & 1) << 5)); }
__host__ __device__ __forceinline__ void stage_rc(int b, int& R, int& C) { const int st = b / 1024, sb = b % 1024, swz = sb ^ (((sb >> 9) & 1) << 5); R = (st >> 1) * 16 + swz / 64; C = (st & 1) * 32 + (swz % 64) / 2; }
__host__ __device__ __forceinline__ int perm32(int rho) { const int n = rho >> 4, i = rho & 15; return 8 * (i >> 2) + 4 * n + (i & 3); }

struct Unit { int pm, pn; };
struct Gemm { const bf16_t* A; const bf16_t* Bt; int M, N, K; };

struct StaticOrder {
    int nM, nN, nwg, G, c;
    __host__ __device__ void init(int M, int N, int G_, int c_) { nM = M / BM; nN = N / BM; nwg = nM * nN; G = G_; c = c_; }
    __host__ __device__ bool next(int i, Unit& u) const {
        const long L = (long)i * G + c; if (L >= nwg) return false;
        int wgid = (int)L; { const int q = nwg / NXCD, r = nwg % NXCD, xcd = wgid % NXCD, off = wgid / NXCD; wgid = (xcd < r ? xcd * (q + 1) : r * (q + 1) + (xcd - r) * q) + off; }
        const int nig = WGM * nN, gid = wgid / nig, fm = gid * WGM, gsz = (nM - fm) < WGM ? (nM - fm) : WGM;
        u.pm = fm + ((wgid % nig) % gsz); u.pn = (wgid % nig) / gsz; return true;
    }
    __device__ __forceinline__ void a_ready(const Unit&) const {}
    __device__ __forceinline__ void done(const Unit&) const {}
};

__device__ __forceinline__ unsigned cvt_pk_bf16(float lo, float hi) { unsigned r; asm volatile("v_cvt_pk_bf16_f32 %0, %1, %2" : "=v"(r) : "v"(lo), "v"(hi)); return r; }
typedef float f32x2 __attribute__((ext_vector_type(2)));
__device__ __forceinline__ f32x2 gelu_pk(f32x2 v) {
    const f32x2 av = __builtin_elementwise_abs(v), d = av * 0.2316418882f + 1.0f;
    f32x2 t; t.x = __builtin_amdgcn_rcpf(d.x); t.y = __builtin_amdgcn_rcpf(d.y);
    f32x2 q = t * 0.5307027145f + (-0.7265760135f); q = q * t + 0.7107068705f; q = q * t + (-0.142248368f); q = q * t + 0.127414796f; q = q * t;
    const f32x2 s = (v * v) * (-0.72134752044f);
    f32x2 e; e.x = __builtin_amdgcn_exp2f(s.x); e.y = __builtin_amdgcn_exp2f(s.y);
    const f32x2 m = v * (q * e), r = v - m;
    f32x2 o; o.x = v.x < 0.f ? m.x : r.x; o.y = v.y < 0.f ? m.y : r.y; return o;
}

template <int ACT  > struct EpiBf16 {
    static constexpr bool PERM = true, AFTER_DRAIN = false; static_assert(ACT == 0 || ACT == 1, "EpiBf16: ACT is 0 (none) or 1 (gelu_pk)");
    bf16_t* O; int ldc; const float* bias; int split_cols; size_t split_stride; float scale0;
    __device__ __forceinline__ void operator()(const f32x4 (&acc)[2][2][4][2], const Unit& u, int wr, int wc, int fr, int fq) const {
        const int row0 = u.pm * BM + wr * 64 + fr; int colt = u.pn * BM; bf16_t* base = O;
        float sc = 1.f; if (split_cols) { const int t = colt / split_cols; base += (size_t)t * split_stride; colt -= t * split_cols; if (t == 0) sc = scale0; }
        const int col0 = colt + wc * 32 + 8 * fq, bcol0 = u.pn * BM + wc * 32 + 8 * fq;
        f32x4 bv[2][2];
#pragma unroll
        for (int bj = 0; bj < 2; ++bj)
#pragma unroll
            for (int n = 0; n < 2; ++n) bv[bj][n] = bias ? *(const f32x4*)(bias + bcol0 + bj * HALF + 4 * n) : (f32x4){0.f, 0.f, 0.f, 0.f};
#pragma unroll
        for (int ai = 0; ai < 2; ++ai)
#pragma unroll
            for (int m = 0; m < 4; ++m) { bf16_t* rowp = base + (size_t)(row0 + ai * HALF + m * 16) * ldc + col0;
#pragma unroll
                for (int bj = 0; bj < 2; ++bj) { f32x4 v0 = acc[ai][bj][m][0] + bv[bj][0], v1 = acc[ai][bj][m][1] + bv[bj][1];
                    if (ACT == 1) { f32x2 a = gelu_pk((f32x2){v0[0], v0[1]}), b = gelu_pk((f32x2){v0[2], v0[3]}), c = gelu_pk((f32x2){v1[0], v1[1]}), d = gelu_pk((f32x2){v1[2], v1[3]});
                        v0 = (f32x4){a.x, a.y, b.x, b.y}; v1 = (f32x4){c.x, c.y, d.x, d.y}; }
                    v0 = v0 * sc; v1 = v1 * sc; u32x4 w; w.x = cvt_pk_bf16(v0[0], v0[1]); w.y = cvt_pk_bf16(v0[2], v0[3]); w.z = cvt_pk_bf16(v1[0], v1[1]); w.w = cvt_pk_bf16(v1[2], v1[3]);
                    *(u32x4*)(rowp + bj * HALF) = w; } }
    }
};

struct PanelStats {
    unsigned* xbuf;
    unsigned* cnt;
    unsigned* tmo;
    int ntn; float eps;
    unsigned code;
    __device__ __forceinline__ bool run(const f32x4 (&v)[2][2][4][2], const Unit& u, int wr, int wc, int fr, int fq, PG8_LAS unsigned char* lds, int wid, int lane) const {
        typedef float f32x2v __attribute__((ext_vector_type(2)));
        PG8_LAS f32x2v* P = (PG8_LAS f32x2v*)lds;
        PG8_LAS f32x2v* S = (PG8_LAS f32x2v*)(lds + 8192);
        PG8_LAS unsigned* flag = (PG8_LAS unsigned*)(lds + 8192 + 2048);
#pragma unroll
        for (int ai = 0; ai < 2; ++ai)
#pragma unroll
            for (int m = 0; m < 4; ++m) {
                float s = 0.f;
#pragma unroll
                for (int bj = 0; bj < 2; ++bj)
#pragma unroll
                    for (int n = 0; n < 2; ++n) { const f32x4 x = v[ai][bj][m][n]; s += (x[0] + x[1]) + (x[2] + x[3]); }
                s += __shfl_xor(s, 16); s += __shfl_xor(s, 32);
                const float mw = s * (1.0f / 64.0f); float q = 0.f;
#pragma unroll
                for (int bj = 0; bj < 2; ++bj)
#pragma unroll
                    for (int n = 0; n < 2; ++n) { const f32x4 d = v[ai][bj][m][n] - mw; q += (d[0] * d[0] + d[1] * d[1]) + (d[2] * d[2] + d[3] * d[3]); }
                q += __shfl_xor(q, 16); q += __shfl_xor(q, 32);
                if (fq == 0) P[(ai * HALF + wr * 64 + m * 16 + fr) * 4 + wc] = (f32x2v){mw, q};
            }
        asm volatile("s_waitcnt lgkmcnt(0)" ::: "memory"); __builtin_amdgcn_s_barrier(); asm volatile("" ::: "memory");
#if defined(BROKEN_EXCHANGE_NO_WAIT)
#warning BROKEN CONTROL BUILD: the row-statistics exchange does not wait; results are wrong by design
        if (blockIdx.x >= 64) { const long long t0_ = clock64(); while (clock64() - t0_ < 60000) __builtin_amdgcn_s_sleep(8); }
#endif
        const int row = wid * 32 + (lane & 31);
        if (lane < 32) {
            const f32x2v a = P[row * 4 + 0], b = P[row * 4 + 1], c = P[row * 4 + 2], d = P[row * 4 + 3];
            const float mt = (a.x + b.x + c.x + d.x) * 0.25f;
            const float da = a.x - mt, db = b.x - mt, dc = c.x - mt, dd = d.x - mt;
            const float m2 = (a.y + b.y) + (c.y + d.y) + 64.0f * ((da * da + db * db) + (dc * dc + dd * dd));
            unsigned long long* slot = (unsigned long long*)xbuf + ((size_t)(u.pm * BM + row) * 4 + u.pn);
            __hip_atomic_store(slot, ((unsigned long long)__float_as_uint(m2) << 32) | __float_as_uint(mt), __ATOMIC_RELAXED, __HIP_MEMORY_SCOPE_AGENT);
        }
        asm volatile("s_waitcnt vmcnt(0)" ::: "memory");
        if (lane == 0) __hip_atomic_fetch_add(cnt + 64 * u.pm, 1u, __ATOMIC_RELAXED, __HIP_MEMORY_SCOPE_AGENT);
        if (wid == 0) {
            bool dead = false; const unsigned long long t0 = __builtin_amdgcn_s_memrealtime(); const unsigned want = 8u * (unsigned)ntn;
            for (;;) {
#if defined(BROKEN_EXCHANGE_NO_WAIT)
                break;
#endif
                if ((unsigned)__builtin_amdgcn_readfirstlane(__hip_atomic_load(cnt + 64 * u.pm, __ATOMIC_RELAXED, __HIP_MEMORY_SCOPE_AGENT)) >= want) break;
                if (__builtin_amdgcn_s_memrealtime() - t0 > 2000000ull) {
                    if (lane == 0) { unsigned expect = 0u; __hip_atomic_compare_exchange_strong(tmo + 1, &expect, code | (unsigned)(u.pm & 0xff), __ATOMIC_RELAXED, __ATOMIC_RELAXED, __HIP_MEMORY_SCOPE_AGENT);
                                     __hip_atomic_store(tmo, 1u, __ATOMIC_RELAXED, __HIP_MEMORY_SCOPE_AGENT); }
                    dead = true; break; }
                __builtin_amdgcn_s_sleep(2);
            }
            __builtin_amdgcn_fence(__ATOMIC_ACQUIRE, "agent");
            if (lane == 0) flag[0] = dead ? 1u : 0u;
        }
        asm volatile("s_waitcnt vmcnt(0) lgkmcnt(0)" ::: "memory"); __builtin_amdgcn_s_barrier(); asm volatile("" ::: "memory");
        const bool bad = flag[0] != 0u;
        if (lane < 32) {
            const unsigned long long* slot = (const unsigned long long*)xbuf + (size_t)(u.pm * BM + row) * 4; float mt[4], m2[4]; float ms = 0.f;
#pragma unroll
            for (int t = 0; t < 4; ++t) { if (t < ntn) { const unsigned long long w = __hip_atomic_load(slot + t, __ATOMIC_RELAXED, __HIP_MEMORY_SCOPE_AGENT); mt[t] = __uint_as_float((unsigned)w); m2[t] = __uint_as_float((unsigned)(w >> 32)); } else { mt[t] = 0.f; m2[t] = 0.f; } ms += mt[t]; }
            const float mean = ms / (float)ntn; float q = 0.f;
#pragma unroll
            for (int t = 0; t < 4; ++t) if (t < ntn) { const float dm = mt[t] - mean; q += m2[t] + 256.0f * dm * dm; }
            S[row] = (f32x2v){mean, 1.0f / sqrtf(q / (256.0f * (float)ntn) + eps)};
        }
        asm volatile("s_waitcnt lgkmcnt(0)" ::: "memory"); __builtin_amdgcn_s_barrier(); asm volatile("" ::: "memory");
        return bad;
    }
};
struct EpiLnRes {
    static constexpr bool PERM = false, AFTER_DRAIN = true;
    const float* base; float* out; int ldc; const float* bias; PanelStats st; unsigned poison;
    __device__ __forceinline__ void fused(f32x4 (&acc)[2][2][4][2], const Unit& u, int wr, int wc, int fr, int fq, PG8_LAS unsigned char* lds, int wid, int lane) const {
        typedef float f32x2v __attribute__((ext_vector_type(2)));
        const PG8_LAS f32x2v* S = (const PG8_LAS f32x2v*)(lds + 8192);
        const int col0 = u.pn * BM + wc * 32 + 4 * fq;
#pragma unroll
        for (int bj = 0; bj < 2; ++bj)
#pragma unroll
            for (int n = 0; n < 2; ++n) { const f32x4 bv = bias ? *(const f32x4*)(bias + col0 + bj * HALF + n * 16) : (f32x4){0.f, 0.f, 0.f, 0.f};
#pragma unroll
                for (int ai = 0; ai < 2; ++ai)
#pragma unroll
                    for (int m = 0; m < 4; ++m) acc[ai][bj][m][n] += bv; }
        f32x4 pre[4][2][2];
#pragma unroll
        for (int m = 0; m < 4; ++m) { const size_t off = (size_t)(u.pm * BM + wr * 64 + m * 16 + fr) * ldc + col0;
#pragma unroll
            for (int bj = 0; bj < 2; ++bj)
#pragma unroll
                for (int n = 0; n < 2; ++n) pre[m][bj][n] = *(const f32x4*)(base + off + bj * HALF + n * 16); }
        const bool bad = st.run(acc, u, wr, wc, fr, fq, lds, wid, lane) || poison != 0u;
        const float qnan = __builtin_nanf("");
#pragma unroll
        for (int ai = 0; ai < 2; ++ai)
#pragma unroll
            for (int m = 0; m < 4; ++m) { const int r = ai * HALF + wr * 64 + m * 16 + fr; const f32x2v sr = S[r]; const size_t off = (size_t)(u.pm * BM + r) * ldc + col0;
#pragma unroll
                for (int bj = 0; bj < 2; ++bj)
#pragma unroll
                    for (int n = 0; n < 2; ++n) { const f32x4 bs = ai == 0 ? pre[m][bj][n] : *(const f32x4*)(base + off + bj * HALF + n * 16); f32x4 o = bs + (acc[ai][bj][m][n] - sr.x) * sr.y;
                        if (bad) o = (f32x4){qnan, qnan, qnan, qnan}; *(f32x4*)(out + off + bj * HALF + n * 16) = o; }
                if (m & 1) asm volatile("" ::: "memory"); }
    }
};
struct EpiLnResLn {
    static constexpr bool PERM = false, AFTER_DRAIN = true;
    const float* base; float* out; bf16_t* xn; int ldc; const float* bias; PanelStats st1, st2; unsigned poison;
    __device__ __forceinline__ void fused(f32x4 (&acc)[2][2][4][2], const Unit& u, int wr, int wc, int fr, int fq, PG8_LAS unsigned char* lds, int wid, int lane) const {
        typedef float f32x2v __attribute__((ext_vector_type(2))); typedef unsigned u32x2v __attribute__((ext_vector_type(2)));
        const PG8_LAS f32x2v* S = (const PG8_LAS f32x2v*)(lds + 8192);
        const int col0 = u.pn * BM + wc * 32 + 4 * fq;
#pragma unroll
        for (int bj = 0; bj < 2; ++bj)
#pragma unroll
            for (int n = 0; n < 2; ++n) { const f32x4 bv = bias ? *(const f32x4*)(bias + col0 + bj * HALF + n * 16) : (f32x4){0.f, 0.f, 0.f, 0.f};
#pragma unroll
                for (int ai = 0; ai < 2; ++ai)
#pragma unroll
                    for (int m = 0; m < 4; ++m) acc[ai][bj][m][n] += bv; }
        bool bad = st1.run(acc, u, wr, wc, fr, fq, lds, wid, lane) || poison != 0u;
        const float qnan = __builtin_nanf("");
#pragma unroll
        for (int ai = 0; ai < 2; ++ai)
#pragma unroll
            for (int m = 0; m < 4; ++m) { const int r = ai * HALF + wr * 64 + m * 16 + fr; const f32x2v sr = S[r]; const size_t off = (size_t)(u.pm * BM + r) * ldc + col0;
#pragma unroll
                for (int bj = 0; bj < 2; ++bj)
#pragma unroll
                    for (int n = 0; n < 2; ++n) { const f32x4 bs = *(const f32x4*)(base + off + bj * HALF + n * 16); acc[ai][bj][m][n] = bs + (acc[ai][bj][m][n] - sr.x) * sr.y; }
                asm volatile("" : "+v"(acc[ai][0][m][0]), "+v"(acc[ai][0][m][1]), "+v"(acc[ai][1][m][0]), "+v"(acc[ai][1][m][1]));
                if (m & 1) asm volatile("" ::: "memory"); }
        const bool bad1 = bad;
        bad = st2.run(acc, u, wr, wc, fr, fq, lds, wid, lane) || bad;
#pragma unroll
        for (int ai = 0; ai < 2; ++ai)
#pragma unroll
            for (int m = 0; m < 4; ++m) { const int r = ai * HALF + wr * 64 + m * 16 + fr; const f32x2v sr = S[r]; const size_t off = (size_t)(u.pm * BM + r) * ldc + col0;
#pragma unroll
                for (int bj = 0; bj < 2; ++bj)
#pragma unroll
                    for (int n = 0; n < 2; ++n) { const f32x4 x1 = acc[ai][bj][m][n]; *(f32x4*)(out + off + bj * HALF + n * 16) = bad1 ? (f32x4){qnan, qnan, qnan, qnan} : x1;
                        const f32x4 o = (x1 - sr.x) * sr.y; u32x2v w; w.x = cvt_pk_bf16(o[0], o[1]); w.y = cvt_pk_bf16(o[2], o[3]);
                        if (bad) { w.x = 0x7fc07fc0u; w.y = 0x7fc07fc0u; } *(u32x2v*)(xn + off + bj * HALF + n * 16) = w; }
                asm volatile("" ::: "memory"); }
    }
};

template <class Epi, class Sched, bool ALIGN_EPI = false, bool SP2 = false>
__device__ __forceinline__ void gemm_phase(PG8_LAS unsigned char* lds, const Gemm g, const Sched& S, const Epi& E) {
    int tid_ = threadIdx.x; asm volatile("" : "+v"(tid_));
    const int tid = tid_, wid = __builtin_amdgcn_readfirstlane(tid >> 6), lane = tid & 63, wr = wid >> 2, wc = wid & 3, fr = lane & 15, fq = lane >> 4;
    const int K = g.K, nt = K / BK;
    unsigned voffA[2], voffB[2];
#pragma unroll
    for (int i = 0; i < 2; ++i) { int R, C; stage_rc(tid * 16 + i * 8192, R, C); const int Rb = Epi::PERM ? ((R & ~31) + perm32(R & 31)) : R;
        voffA[i] = (unsigned)(R * K + C) * 2u; voffB[i] = (unsigned)(Rb * K + C) * 2u; }
    const size_t kstep = (size_t)(BK * 2);
    const size_t hstep = (size_t)HALF * K * 2;
    const size_t tstep = 2 * hstep;
    const unsigned ldsw = (unsigned)wid * 1024u;
    const int aoff = lds_byte(wr * 64 + fr, fq * 8), boff = lds_byte(wc * 32 + fr, fq * 8);
#define PG8_SA(b, h) (((b) * 2 + (h)) * HTB)
#define PG8_SB(b, h) ((4 + (b) * 2 + (h)) * HTB)
#define PG8_STAGE(bufoff, gbase, voff) do { _Pragma("unroll") for (int _i = 0; _i < 2; ++_i) \
        __builtin_amdgcn_global_load_lds((const unsigned*)((const char*)(gbase) + (voff)[_i]), (PG8_LAS unsigned*)(lds + (bufoff) + ldsw + _i * 8192), 16, 0, 0); } while (0)
#define PG8_LDA(dst, b, h) do { _Pragma("unroll") for (int m = 0; m < 4; ++m) _Pragma("unroll") for (int k = 0; k < 2; ++k) dst[m][k] = *(const PG8_LAS bf16x8*)(lds + PG8_SA(b, h) + aoff + m * 2048 + k * 1024); } while (0)
#define PG8_LDB(dst, b, h) do { _Pragma("unroll") for (int n = 0; n < 2; ++n) _Pragma("unroll") for (int k = 0; k < 2; ++k) dst[n][k] = *(const PG8_LAS bf16x8*)(lds + PG8_SB(b, h) + boff + n * 2048 + k * 1024); } while (0)
#define PG8_MMA(ai, bj, At, Bt) do { __builtin_amdgcn_s_setprio(1); _Pragma("unroll") for (int m = 0; m < 4; ++m) _Pragma("unroll") for (int n = 0; n < 2; ++n) _Pragma("unroll") for (int k = 0; k < 2; ++k) \
        acc[ai][bj][m][n] = __builtin_amdgcn_mfma_f32_16x16x32_bf16(Bt[n][k], At[m][k], acc[ai][bj][m][n], 0, 0, 0); __builtin_amdgcn_s_setprio(0); } while (0)
#define PG8_WAIT_V(n) asm volatile("s_waitcnt vmcnt(" #n ")" ::: "memory")
#define PG8_WAIT_L(n) asm volatile("s_waitcnt lgkmcnt(" #n ")" ::: "memory")
#define PG8_BAR __builtin_amdgcn_s_barrier()
#define PG8_SCHED __builtin_amdgcn_sched_barrier(0)
    Unit cur, nxt; int ui = 0;
    if (!S.next(0, cur)) return;
    f32x4 acc[2][2][4][2];
#pragma unroll
    for (int a = 0; a < 2; ++a)
#pragma unroll
        for (int b = 0; b < 2; ++b)
#pragma unroll
            for (int m = 0; m < 4; ++m)
#pragma unroll
                for (int n = 0; n < 2; ++n) acc[a][b][m][n] = (f32x4){0.f, 0.f, 0.f, 0.f};
    bf16x8 At[4][2], B0[2][2], B1[2][2];
    const char* cA = (const char*)g.A + (size_t)cur.pm * tstep; const char* cB = (const char*)g.Bt + (size_t)cur.pn * tstep;
    S.a_ready(cur);
    if constexpr (SP2) {
        PG8_STAGE(PG8_SB(0, 0), cB, voffB); PG8_STAGE(PG8_SB(0, 1), cB + hstep, voffB); PG8_STAGE(PG8_SA(0, 0), cA, voffA); PG8_STAGE(PG8_SA(0, 1), cA + hstep, voffA);
        if (wr == 1) PG8_BAR;
        PG8_WAIT_V(2); PG8_BAR;
        PG8_STAGE(PG8_SB(1, 0), cB + kstep, voffB); PG8_STAGE(PG8_SA(1, 0), cA + kstep, voffA); PG8_STAGE(PG8_SB(1, 1), cB + hstep + kstep, voffB);
        PG8_WAIT_V(6); PG8_BAR;
    } else {
        PG8_STAGE(PG8_SB(0, 0), cB, voffB); PG8_STAGE(PG8_SA(0, 0), cA, voffA); PG8_STAGE(PG8_SB(0, 1), cB + hstep, voffB); PG8_STAGE(PG8_SA(0, 1), cA + hstep, voffA);
        if (wr == 1) PG8_BAR;
        PG8_WAIT_V(4); PG8_BAR;
        PG8_STAGE(PG8_SB(1, 0), cB + kstep, voffB); PG8_STAGE(PG8_SA(1, 0), cA + kstep, voffA); PG8_STAGE(PG8_SB(1, 1), cB + hstep + kstep, voffB);
        PG8_WAIT_V(6); PG8_BAR;
    }
    for (;;) {
        const bool has_next = S.next(ui + 1, nxt);
        const char* nA = has_next ? (const char*)g.A + (size_t)nxt.pm * tstep : cA; const char* nB = has_next ? (const char*)g.Bt + (size_t)nxt.pn * tstep : cB;
        for (int t = 0; t < nt; t += 2) {
            const bool last = (t == nt - 2);
            const char* a1 = cA + (size_t)(t + 1) * kstep;
            const char* a2 = last ? nA : cA + (size_t)(t + 2) * kstep; const char* b2 = last ? nB : cB + (size_t)(t + 2) * kstep;
            const char* a3 = a2 + kstep; const char* b3 = b2 + kstep;
            if (last && has_next) S.a_ready(nxt);
            if constexpr (SP2) {
            PG8_LDB(B0, 0, 0); PG8_LDB(B1, 0, 1); PG8_SCHED; PG8_LDA(At, 0, 0); PG8_STAGE(PG8_SA(1, 1), a1 + hstep, voffA);
            PG8_WAIT_V(8); PG8_WAIT_L(0); PG8_BAR; PG8_MMA(0, 0, At, B0); PG8_MMA(0, 1, At, B1); PG8_BAR; PG8_SCHED;
            PG8_LDA(At, 0, 1); PG8_STAGE(PG8_SB(0, 0), b2, voffB); PG8_STAGE(PG8_SB(0, 1), b2 + hstep, voffB); PG8_STAGE(PG8_SA(0, 0), a2, voffA);
            PG8_WAIT_V(8); PG8_WAIT_L(0); PG8_BAR; PG8_MMA(1, 0, At, B0); PG8_MMA(1, 1, At, B1); PG8_BAR; PG8_SCHED;
            PG8_LDB(B0, 1, 0); PG8_LDB(B1, 1, 1); PG8_SCHED; PG8_LDA(At, 1, 0); PG8_STAGE(PG8_SA(0, 1), a2 + hstep, voffA);
            PG8_WAIT_V(8); PG8_WAIT_L(0); PG8_BAR; PG8_MMA(0, 0, At, B0); PG8_MMA(0, 1, At, B1); PG8_BAR; PG8_SCHED;
            PG8_LDA(At, 1, 1); PG8_STAGE(PG8_SB(1, 0), b3, voffB); PG8_STAGE(PG8_SB(1, 1), b3 + hstep, voffB); PG8_STAGE(PG8_SA(1, 0), a3, voffA);
            PG8_WAIT_V(8); PG8_WAIT_L(0); PG8_BAR; PG8_MMA(1, 0, At, B0); PG8_MMA(1, 1, At, B1); PG8_BAR; PG8_SCHED;
            } else {
            PG8_LDB(B0, 0, 0); PG8_SCHED; PG8_LDA(At, 0, 0); PG8_STAGE(PG8_SA(1, 1), a1 + hstep, voffA);
            PG8_WAIT_L(8); PG8_BAR; PG8_WAIT_L(0); PG8_MMA(0, 0, At, B0); PG8_BAR; PG8_SCHED;
            PG8_LDB(B1, 0, 1); PG8_STAGE(PG8_SB(0, 0), b2, voffB);
            PG8_BAR; PG8_WAIT_L(0); PG8_MMA(0, 1, At, B1); PG8_BAR;
            PG8_LDA(At, 0, 1); PG8_STAGE(PG8_SA(0, 0), a2, voffA);
            PG8_BAR; PG8_WAIT_L(0); PG8_MMA(1, 0, At, B0); PG8_BAR; PG8_SCHED;
            PG8_STAGE(PG8_SB(0, 1), b2 + hstep, voffB);
            PG8_WAIT_V(6); PG8_BAR; PG8_MMA(1, 1, At, B1); PG8_BAR;
            PG8_LDB(B0, 1, 0); PG8_SCHED; PG8_LDA(At, 1, 0); PG8_STAGE(PG8_SA(0, 1), a2 + hstep, voffA);
            PG8_WAIT_L(8); PG8_BAR; PG8_WAIT_L(0); PG8_MMA(0, 0, At, B0); PG8_BAR; PG8_SCHED;
            PG8_LDB(B1, 1, 1); PG8_STAGE(PG8_SB(1, 0), b3, voffB);
            PG8_BAR; PG8_WAIT_L(0); PG8_MMA(0, 1, At, B1); PG8_BAR;
            PG8_LDA(At, 1, 1); PG8_STAGE(PG8_SA(1, 0), a3, voffA);
            PG8_BAR; PG8_WAIT_L(0); PG8_MMA(1, 0, At, B0); PG8_BAR; PG8_SCHED;
            PG8_STAGE(PG8_SB(1, 1), b3 + hstep, voffB);
            PG8_WAIT_V(6); PG8_BAR; PG8_MMA(1, 1, At, B1); PG8_BAR;
            }
        }
        if constexpr (ALIGN_EPI) { if (wr == 0) PG8_BAR; }
        if constexpr (!Epi::AFTER_DRAIN) { E(acc, cur, wr, wc, fr, fq); S.done(cur); }
        if (!has_next) break;
#pragma unroll
        for (int a = 0; a < 2; ++a)
#pragma unroll
            for (int b = 0; b < 2; ++b)
#pragma unroll
                for (int m = 0; m < 4; ++m)
#pragma unroll
                    for (int n = 0; n < 2; ++n) acc[a][b][m][n] = (f32x4){0.f, 0.f, 0.f, 0.f};
        cur = nxt; cA = nA; cB = nB; ++ui;
        if constexpr (ALIGN_EPI) { if (wr == 1) PG8_BAR; }
    }
    PG8_WAIT_V(0);
    if constexpr (!ALIGN_EPI) { if (wr == 0) PG8_BAR; }
    PG8_BAR;
    if constexpr (Epi::AFTER_DRAIN) { E.fused(acc, cur, wr, wc, fr, fq, lds, wid, lane); S.done(cur); }
#undef PG8_SA
#undef PG8_SB
#undef PG8_STAGE
#undef PG8_LDA
#undef PG8_LDB
#undef PG8_MMA
#undef PG8_WAIT_V
#undef PG8_WAIT_L
#undef PG8_BAR
#undef PG8_SCHED
}
}
namespace pg8 {
typedef float f32x2c __attribute__((ext_vector_type(2))); typedef __bf16 bf16x2c __attribute__((ext_vector_type(2)));
__device__ __forceinline__ unsigned cvt2(float lo, float hi) { f32x2c v = {lo, hi}; bf16x2c b = __builtin_convertvector(v, bf16x2c); return __builtin_bit_cast(unsigned, b); }
struct EpiStore {
    static constexpr bool PERM = true, AFTER_DRAIN = false;
    bf16_t* O; int ldc; int split_cols; size_t split_stride; int act; int act_from; int tr_tile;
    __device__ __forceinline__ void operator()(const f32x4 (&acc)[2][2][4][2], const Unit& u, int wr, int wc, int fr, int fq) const {
        const int row0 = u.pm * BM + wr * 64 + fr; int colt = u.pn * BM; bf16_t* base = O; int a = act;
        bool tr = false;
        if (split_cols) { const int t = colt / split_cols; base += (size_t)t * split_stride; colt -= t * split_cols; if (act == 1 && t < act_from) a = 0; tr = (t == tr_tile); }
        const int col0 = colt + wc * 32 + 8 * fq;
        if (tr) {
#pragma unroll
            for (int ai = 0; ai < 2; ++ai)
#pragma unroll
                for (int m = 0; m < 4; ++m) { const int row = row0 + ai * HALF + m * 16; bf16_t* cp = base + ((size_t)(row >> 13) * 1024 + col0) * 8192 + (row & 8191);
#pragma unroll
                    for (int bj = 0; bj < 2; ++bj)
#pragma unroll
                        for (int n = 0; n < 2; ++n)
#pragma unroll
                            for (int e = 0; e < 4; ++e) cp[(size_t)(bj * HALF + 4 * n + e) * 8192] = (bf16_t)(cvt2(acc[ai][bj][m][n][e], 0.f) & 0xffffu); }
            return;
        }
#pragma unroll
        for (int ai = 0; ai < 2; ++ai)
#pragma unroll
            for (int m = 0; m < 4; ++m) { bf16_t* rowp = base + (size_t)(row0 + ai * HALF + m * 16) * ldc + col0;
#pragma unroll
                for (int bj = 0; bj < 2; ++bj) { f32x4 v0 = acc[ai][bj][m][0], v1 = acc[ai][bj][m][1];
                    if (a == 1) {
#pragma unroll
                        for (int e = 0; e < 4; ++e) { v0[e] = __builtin_amdgcn_rcpf(1.0f + __expf(-v0[e])); v1[e] = __builtin_amdgcn_rcpf(1.0f + __expf(-v1[e])); }
                    } else if (a == 2) {
#pragma unroll
                        for (int e = 0; e < 4; ++e) { float p = fmaxf(v0[e], 0.f), q = fmaxf(v1[e], 0.f); v0[e] = p * p; v1[e] = q * q; }
                    }
                    u32x4 w; w.x = cvt2(v0[0], v0[1]); w.y = cvt2(v0[2], v0[3]); w.z = cvt2(v1[0], v1[1]); w.w = cvt2(v1[2], v1[3]);
                    *(u32x4*)(rowp + bj * HALF) = w; } }
    }
};
struct GateSched {
    StaticOrder base;
    __device__ __forceinline__ bool next(int i, Unit& u) const { Unit ub; if (!base.next(i / 3, ub)) return false; const int br = i % 3; u.pm = ub.pm + 64 * br; u.pn = ub.pn + 4 * br; return true; }
    __device__ __forceinline__ void a_ready(const Unit&) const {}
    __device__ __forceinline__ void done(const Unit&) const {}
};
struct EpiGate {
    static constexpr bool PERM = true, AFTER_DRAIN = false;
    const bf16_t* G; float* MG; bf16_t* MGb; size_t gstride;
    __device__ __forceinline__ void operator()(const f32x4 (&acc)[2][2][4][2], const Unit& u, int wr, int wc, int fr, int fq) const {
        const int mode = u.pm >> 6, pm = u.pm & 63, pn = u.pn & 3; const bf16_t* Gb = G + (size_t)mode * gstride;
        const int row0 = pm * BM + wr * 64 + fr; const int col0 = pn * BM + wc * 32 + 8 * fq;
#pragma unroll
        for (int ai = 0; ai < 2; ++ai)
#pragma unroll
            for (int m = 0; m < 4; ++m) { const size_t off = (size_t)(row0 + ai * HALF + m * 16) * 1024 + col0;
#pragma unroll
                for (int bj = 0; bj < 2; ++bj) { const size_t o2 = off + bj * HALF;
                    const u32x4 gw = *(const u32x4*)(Gb + o2);
                    f32x4 g0, g1;
                    g0[0] = __uint_as_float(gw.x << 16); g0[1] = __uint_as_float(gw.x & 0xffff0000u); g0[2] = __uint_as_float(gw.y << 16); g0[3] = __uint_as_float(gw.y & 0xffff0000u);
                    g1[0] = __uint_as_float(gw.z << 16); g1[1] = __uint_as_float(gw.z & 0xffff0000u); g1[2] = __uint_as_float(gw.w << 16); g1[3] = __uint_as_float(gw.w & 0xffff0000u);
                    f32x4 v0 = acc[ai][bj][m][0] * g0, v1 = acc[ai][bj][m][1] * g1;
                    if (mode != 0) { const u32x4 pw = *(const u32x4*)(MGb + o2);
                        v0[0] += __uint_as_float(pw.x << 16); v0[1] += __uint_as_float(pw.x & 0xffff0000u); v0[2] += __uint_as_float(pw.y << 16); v0[3] += __uint_as_float(pw.y & 0xffff0000u);
                        v1[0] += __uint_as_float(pw.z << 16); v1[1] += __uint_as_float(pw.z & 0xffff0000u); v1[2] += __uint_as_float(pw.w << 16); v1[3] += __uint_as_float(pw.w & 0xffff0000u); }
                    u32x4 w; w.x = cvt2(v0[0], v0[1]); w.y = cvt2(v0[2], v0[3]); w.z = cvt2(v1[0], v1[1]); w.w = cvt2(v1[2], v1[3]); *(u32x4*)(MGb + o2) = w; } }
    }
};
struct EpiRes {
    static constexpr bool PERM = false, AFTER_DRAIN = false;
    const float* base; float* out;
    __device__ __forceinline__ void operator()(const f32x4 (&acc)[2][2][4][2], const Unit& u, int wr, int wc, int fr, int fq) const {
        const int col0 = u.pn * BM + wc * 32 + 4 * fq;
#pragma unroll
        for (int ai = 0; ai < 2; ++ai)
#pragma unroll
            for (int m = 0; m < 4; ++m) { const size_t off = (size_t)(u.pm * BM + ai * HALF + wr * 64 + m * 16 + fr) * 1024 + col0;
#pragma unroll
                for (int bj = 0; bj < 2; ++bj)
#pragma unroll
                    for (int n = 0; n < 2; ++n) { const f32x4 bs = *(const f32x4*)(base + off + bj * HALF + n * 16); *(f32x4*)(out + off + bj * HALF + n * 16) = bs + acc[ai][bj][m][n]; } }
    }
};
}
constexpr int BATCH = 2, SEQ = 8192, DM = 1024, M = BATCH * SEQ, NIN = 13320, FF = 4096;
constexpr float EPS = 1e-6f;
constexpr float SB_THR = -30.0f;
constexpr size_t MiB = 1u << 20;
constexpr size_t WS_GATES = 1 * MiB;
constexpr size_t WS_MLOC = 1 * MiB + 512 * 1024, WS_BLAST = WS_MLOC + 4096, WS_MST = WS_BLAST + 4096;
constexpr size_t WS_WIN = 2 * MiB, WS_WML = 28 * MiB, WS_WSC = 30 * MiB, WS_WSB = 32 * MiB, WS_WOUT = 34 * MiB, WS_WUP = 36 * MiB, WS_WDN = 44 * MiB;
constexpr size_t WS_XN = 52 * MiB, WS_YML = 84 * MiB, WS_BIG = 116 * MiB;
constexpr size_t WS_PA = WS_BIG;
constexpr size_t WS_ST = 244 * MiB, WS_DN = 372 * MiB;
constexpr size_t WS_P2 = WS_BIG;
constexpr size_t WS_YSC = WS_XN, WS_YSB = WS_P2;
constexpr size_t WS_MG = WS_BIG + 32 * MiB, WS_MGB = WS_BIG + 96 * MiB, WS_HB = WS_BIG + 128 * MiB;
constexpr size_t WS_END = 404 * MiB;
constexpr int LDS_BYTES = 147456;
constexpr int NPH = 12;

#ifndef DRYLVL
#define DRYLVL 0
#endif
#ifndef DUP_MASK
#define DUP_MASK 0
#endif
#ifndef PHMASK
#define PHMASK 0x1fff
#endif
#define LAS __attribute__((address_space(3)))
typedef unsigned short bf16;
typedef unsigned v4u __attribute__((ext_vector_type(4)));
typedef unsigned v2u __attribute__((ext_vector_type(2)));
typedef float f32x4 __attribute__((ext_vector_type(4)));
typedef short bf16x8 __attribute__((ext_vector_type(8)));
__device__ __forceinline__ float bflo(unsigned w) { return __uint_as_float(w << 16); }
__device__ __forceinline__ float bfhi(unsigned w) { return __uint_as_float(w & 0xffff0000u); }
__device__ __forceinline__ float bf2f(unsigned short h) { return __uint_as_float((unsigned)h << 16); }
typedef float f32x2_t __attribute__((ext_vector_type(2))); typedef __bf16 bf16x2_t __attribute__((ext_vector_type(2)));
__device__ __forceinline__ unsigned pk2(float lo, float hi) { f32x2_t v = {lo, hi}; bf16x2_t b = __builtin_convertvector(v, bf16x2_t); return __builtin_bit_cast(unsigned, b); }
__device__ __forceinline__ unsigned short f2bf(float f) { return (unsigned short)(pk2(f, 0.f) & 0xffffu); }
__device__ __forceinline__ float wave_sum(float v) {
#pragma unroll
    for (int o = 1; o < 64; o <<= 1) v += __shfl_xor(v, o);
    return v;
}
__device__ __forceinline__ float wave_max(float v) {
#pragma unroll
    for (int o = 1; o < 64; o <<= 1) v = fmaxf(v, __shfl_xor(v, o));
    return v;
}
__device__ __forceinline__ float wave_prefix(float v, int lane) {
#pragma unroll
    for (int o = 1; o < 64; o <<= 1) { const float n = __shfl_up(v, o); if (lane >= o) v += n; }
    return v;
}
__device__ __forceinline__ float log_sigmoid(float x) { return fminf(x, 0.f) - __logf(1.0f + __expf(-fabsf(x))); }

#define XB_TMO      128
#define XB_XCNT(j)  (256  + 64 * (j))
#define XB_XSUB(j)  (1280 + 64 * (j))
#define XB_XGEN(j)  (2304 + 64 * (j))
#define XB_TOP      3328
#define XB_TOPGEN   3392
#define XCD_BAR_WORDS 3456
#define XB_SPIN_CAP (1u << 18)

__device__ __forceinline__ unsigned xb_ld(unsigned* p)              { return __hip_atomic_load(p, __ATOMIC_RELAXED, __HIP_MEMORY_SCOPE_AGENT); }
__device__ __forceinline__ unsigned xb_add(unsigned* p, unsigned v) { return __hip_atomic_fetch_add(p, v, __ATOMIC_RELAXED, __HIP_MEMORY_SCOPE_AGENT); }
__device__ __forceinline__ unsigned xb_xcc_id() { return (unsigned)__builtin_amdgcn_s_getreg((3 << 11) | 20) & 0xFu; }
#define XB_SPIN(cond, bar) do { unsigned _sp = 0; while (cond) { __builtin_amdgcn_s_sleep(1); \
    if ((++_sp & 255u) == 0u) { if (xb_ld(&(bar)[XB_TMO])) break; if (_sp > XB_SPIN_CAP) { atomicAdd(&(bar)[XB_TMO], 1u); break; } } } } while (0)

struct XcdBarrier {
    unsigned* bar; unsigned x;
    volatile LAS unsigned* st;
};

__device__ __forceinline__ XcdBarrier xcd_barrier_post(unsigned* bar, volatile LAS unsigned* st) {
    XcdBarrier b; b.bar = bar; b.x = xb_xcc_id(); b.st = st;
    if (threadIdx.x == 0) (void)xb_add(&bar[XB_XCNT(b.x)], 1u);
    return b;
}
__device__ __forceinline__ void xcd_barrier_complete(unsigned* bar, unsigned x, unsigned& nloc, unsigned& nx) {
    const unsigned G = gridDim.x * gridDim.y * gridDim.z;
    unsigned sum, cnt, mine, sp = 0u;
    for (;;) {
        sum = 0u; cnt = 0u; mine = 0u;
#pragma unroll
        for (unsigned j = 0; j < 16; ++j) { const unsigned c = xb_ld(&bar[XB_XCNT(j)]); sum += c; cnt += (c > 0u) ? 1u : 0u; mine = (j == x) ? c : mine; }
        if (sum == G) break;
        __builtin_amdgcn_s_sleep(1);
        if ((++sp & 255u) == 0u) { if (xb_ld(&bar[XB_TMO])) break; if (sp > XB_SPIN_CAP) { atomicAdd(&bar[XB_TMO], 1u); break; } }
    }
    nloc = mine > 0u ? mine : 1u; nx = cnt > 0u ? cnt : 1u;
}

__device__ __forceinline__ void xcd_barrier(const XcdBarrier& b) {
    asm volatile("s_waitcnt vmcnt(0)" ::: "memory");
    __syncthreads();
    if (threadIdx.x == 0) {
        unsigned* bar = b.bar;
        __builtin_amdgcn_s_waitcnt(0);
        unsigned nloc = b.st[0], nx = b.st[1];
        if (nloc == 0u) { xcd_barrier_complete(bar, b.x, nloc, nx); b.st[0] = nloc; b.st[1] = nx; }
        const unsigned old = xb_add(&bar[XB_XSUB(b.x)], 1u);
        const unsigned gen = old / nloc;
        if (old + 1u == (gen + 1u) * nloc) {
            __builtin_amdgcn_fence(__ATOMIC_RELEASE, "agent");
            asm volatile("s_waitcnt vmcnt(0)" ::: "memory");
            const unsigned og = xb_add(&bar[XB_TOP], 1u);
            const unsigned tg = og / nx;
            if (og + 1u == (tg + 1u) * nx) xb_add(&bar[XB_TOPGEN], 1u);
            else XB_SPIN(xb_ld(&bar[XB_TOPGEN]) == tg, bar);
            __builtin_amdgcn_fence(__ATOMIC_ACQUIRE, "agent");
            xb_add(&bar[XB_XGEN(b.x)], 1u);
            asm volatile("s_waitcnt vmcnt(0)" ::: "memory");
        } else {
            XB_SPIN(xb_ld(&bar[XB_XGEN(b.x)]) == gen, bar);
            __builtin_amdgcn_fence(__ATOMIC_ACQUIRE, "agent");
            asm volatile("s_waitcnt vmcnt(0)" ::: "memory");
        }
    }
    __syncthreads();
}

constexpr int MISC_OFF = 131072 + 320;
struct Args { const float* in[14]; float* out; unsigned char* ws; int ph_lo, ph_hi; };

__device__ __forceinline__ void transpose_item(const float* W, int pitch, int ncols, int K, bf16* WT, int row_off, LAS float* scr, int item, int lane) {
    const int nblk = ncols / 32, kb = item / nblk, nb = item % nblk, k0 = 64 * kb, n0 = 32 * nb;
    f32x4 wv[8];
#pragma unroll
    for (int i = 0; i < 8; ++i) wv[i] = __builtin_nontemporal_load((const f32x4*)(W + (size_t)(k0 + 8 * i + (lane >> 3)) * pitch + n0 + 4 * (lane & 7)));
#pragma unroll
    for (int i = 0; i < 8; ++i) { LAS float* d = scr + (8 * i + (lane >> 3)) * 33 + 4 * (lane & 7); d[0] = wv[i].x; d[1] = wv[i].y; d[2] = wv[i].z; d[3] = wv[i].w; }
    asm volatile("s_waitcnt lgkmcnt(0)" ::: "memory");
    const int c = lane & 7;
#pragma unroll
    for (int j = 0; j < 4; ++j) { const int n = (lane >> 3) + 8 * j; const LAS float* s = scr + (8 * c) * 33 + n;
        v4u o; o.x = pk2(s[0 * 33], s[1 * 33]); o.y = pk2(s[2 * 33], s[3 * 33]); o.z = pk2(s[4 * 33], s[5 * 33]); o.w = pk2(s[6 * 33], s[7 * 33]);
        *(v4u*)(WT + (size_t)(row_off + n0 + n) * K + k0 + 8 * c) = o; }
    asm volatile("s_waitcnt lgkmcnt(0)" ::: "memory");
}

template <int MODE>
__device__ __forceinline__ void norm_row(const float* xrow, const float* gain, bf16* orow, float* frow, const LAS float* Wg, const float* bias, float* grow, int lane) {
    const f32x4* xr = (const f32x4*)xrow + lane; const f32x4* gr = (const f32x4*)gain + lane;
    f32x4 v[4]; float s = 0.f;
#pragma unroll
    for (int j = 0; j < 4; ++j) { v[j] = xr[64 * j]; s += (v[j].x * v[j].x + v[j].y * v[j].y) + (v[j].z * v[j].z + v[j].w * v[j].w); }
    const float rstd = __builtin_amdgcn_rsqf(wave_sum(s) * (1.0f / DM) + EPS);
#pragma unroll
    for (int j = 0; j < 4; ++j) v[j] = v[j] * rstd * gr[64 * j];
    if (MODE == 2) {
#pragma unroll
        for (int j = 0; j < 4; ++j) ((f32x4*)frow)[lane + 64 * j] = v[j];
    } else {
#pragma unroll
        for (int j = 0; j < 4; ++j) { v2u o; o.x = pk2(v[j].x, v[j].y); o.y = pk2(v[j].z, v[j].w); ((v2u*)orow)[lane + 64 * j] = o; }
    }
    if (MODE == 1) {
        float ga[8];
#pragma unroll
        for (int i = 0; i < 8; ++i) ga[i] = 0.f;
#pragma unroll
        for (int j = 0; j < 4; ++j)
#pragma unroll
            for (int e = 0; e < 4; ++e) { const int k = 4 * lane + 256 * j + e; const f32x4 a = *(const LAS f32x4*)(Wg + k * 8), b = *(const LAS f32x4*)(Wg + k * 8 + 4); const float x = v[j][e];
                ga[0] += x * a.x; ga[1] += x * a.y; ga[2] += x * a.z; ga[3] += x * a.w; ga[4] += x * b.x; ga[5] += x * b.y; ga[6] += x * b.z; ga[7] += x * b.w; }
#pragma unroll
        for (int i = 0; i < 8; ++i) ga[i] = wave_sum(ga[i]);
        if (lane == 0) {
            f32x4 o0 = {ga[0] + bias[0], ga[1] + bias[1], ga[2] + bias[2], ga[3] + bias[3]}, o1 = {ga[4] + bias[4], ga[5] + bias[5], ga[6] + bias[6], ga[7] + bias[7]};
            ((f32x4*)grow)[0] = o0; ((f32x4*)grow)[1] = o1; }
    }
}

template <int MODE>
__device__ __forceinline__ void norm_row_pair(const float* x0, const float* x1, const float* gain, bf16* o0, bf16* o1, float* f0, float* f1, int lane) {
    const f32x4* xa = (const f32x4*)x0 + lane; const f32x4* xb = (const f32x4*)x1 + lane; const f32x4* gr = (const f32x4*)gain + lane;
    f32x4 v[4], w[4], g[4]; float sa = 0.f, sb = 0.f;
#pragma unroll
    for (int j = 0; j < 4; ++j) { v[j] = xa[64 * j]; w[j] = xb[64 * j]; g[j] = gr[64 * j]; }
#pragma unroll
    for (int j = 0; j < 4; ++j) { sa += (v[j].x * v[j].x + v[j].y * v[j].y) + (v[j].z * v[j].z + v[j].w * v[j].w); sb += (w[j].x * w[j].x + w[j].y * w[j].y) + (w[j].z * w[j].z + w[j].w * w[j].w); }
    const float ra = __builtin_amdgcn_rsqf(wave_sum(sa) * (1.0f / DM) + EPS), rb = __builtin_amdgcn_rsqf(wave_sum(sb) * (1.0f / DM) + EPS);
#pragma unroll
    for (int j = 0; j < 4; ++j) { v[j] = v[j] * ra * g[j]; w[j] = w[j] * rb * g[j]; }
    if (MODE == 2) {
#pragma unroll
        for (int j = 0; j < 4; ++j) { ((f32x4*)f0)[lane + 64 * j] = v[j]; ((f32x4*)f1)[lane + 64 * j] = w[j]; }
    } else {
#pragma unroll
        for (int j = 0; j < 4; ++j) { v2u a; a.x = pk2(v[j].x, v[j].y); a.y = pk2(v[j].z, v[j].w); ((v2u*)o0)[lane + 64 * j] = a; v2u b; b.x = pk2(w[j].x, w[j].y); b.y = pk2(w[j].z, w[j].w); ((v2u*)o1)[lane + 64 * j] = b; }
    }
}

__global__ void __launch_bounds__(512, 2) mega(Args args) {
    extern __shared__ __attribute__((aligned(16))) unsigned char lds[];
    cg::grid_group grid = cg::this_grid();
    typedef const Args __attribute__((address_space(4))) CArgs;
#define PH_INIT \
    CArgs* ap = (CArgs*)__builtin_amdgcn_kernarg_segment_ptr(); asm volatile("" : "+s"(ap)); \
    int tid = threadIdx.x; asm volatile("" : "+v"(tid)); \
    LAS unsigned char* L = (LAS unsigned char*)lds; \
    const int lane = tid & 63, wave = __builtin_amdgcn_readfirstlane(tid >> 6); \
    const int G = gridDim.x; const int bx = blockIdx.x; const int vcu = (G % 8 == 0) ? (bx % 8) * (G / 8) + bx / 8 : bx; \
    const int lr = lane & 15, lg = lane >> 4; \
    unsigned char* ws = ap->ws; float* out = ap->out; \
    float* GATES = (float*)(ws + WS_GATES); float* MLOC = (float*)(ws + WS_MLOC); float* BLAST = (float*)(ws + WS_BLAST); float* MST = (float*)(ws + WS_MST); \
    bf16* XN = (bf16*)(ws + WS_XN); bf16* YML = (bf16*)(ws + WS_YML); \
    bf16* ST = (bf16*)(ws + WS_ST); float* DN = (float*)(ws + WS_DN); \
    const size_t TS = (size_t)M * 1024; \
    bf16* PA = (bf16*)(ws + WS_PA); bf16* P2 = (bf16*)(ws + WS_P2); \
    (void)lane; (void)wave; (void)vcu; (void)lr; (void)lg; (void)out; (void)GATES; (void)MLOC; (void)BLAST; (void)MST; (void)XN; (void)YML; (void)ST; (void)DN; (void)TS; (void)PA; (void)P2; (void)L; (void)bx;
    { int t0 = threadIdx.x; if (t0 < 32) ((LAS unsigned*)((LAS unsigned char*)lds + MISC_OFF))[t0] = 0u; }
    __syncthreads();
    { CArgs* apb = (CArgs*)__builtin_amdgcn_kernarg_segment_ptr(); (void)xcd_barrier_post((unsigned*)apb->ws, (volatile LAS unsigned*)((LAS unsigned char*)lds + MISC_OFF) + 8); }
    int ph_lo, ph_hi;
    { CArgs* ap0 = (CArgs*)__builtin_amdgcn_kernarg_segment_ptr(); ph_lo = ap0->ph_lo; ph_hi = ap0->ph_hi; }

    for (int p = ph_lo; p < ph_hi; ++p) {
        if (p > ph_lo) {
            if (ph_hi < 0) grid.sync();
            { CArgs* apb = (CArgs*)__builtin_amdgcn_kernarg_segment_ptr(); XcdBarrier xbr; xbr.bar = (unsigned*)apb->ws; xbr.x = xb_xcc_id(); xbr.st = (volatile LAS unsigned*)((LAS unsigned char*)lds + MISC_OFF) + 8; xcd_barrier(xbr); }
        }
        const int l = p / NPH, k = (p == 2 * NPH) ? NPH : p % NPH;
        const int nrep = ((DUP_MASK >> k) & 1) ? 2 : 1;
        for (int rep = 0; rep < nrep; ++rep) { const bool dry = rep + 1 < nrep; (void)dry;
        switch (k) {
        case 0: { if (!((PHMASK >> 0) & 1)) break; PH_INIT
            LAS float* scr = (LAS float*)(L + wave * 8704);
            const int gw = vcu * 8 + wave, NGW = G * 8;
            const float* win = ap->in[2] + (size_t)l * 1024 * NIN;
            for (int it = gw; it < 12800; it += NGW) {
                if (it < 6656) { const int grp = it >> 9, r = it & 511;
                    const int coff = grp < 4 ? grp * 1024 : (grp == 4 ? 7176 : (grp < 8 ? 4104 + (grp - 5) * 1024 : (grp < 10 ? 8200 + (grp - 8) * 1024 : (grp == 10 ? 11272 : (grp == 11 ? 10248 : 12296)))));
                    transpose_item(win + coff, NIN, 1024, 1024, (bf16*)(ws + WS_WIN), grp * 1024, scr, r, lane); }
                else if (it < 8704) { const int mi = (it - 6656) >> 9, r = (it - 6656) & 511;
                    transpose_item(ap->in[mi == 0 ? 7 : (mi == 1 ? 6 : 6 + mi)] + (size_t)l * 1024 * 1024, 1024, 1024, 1024, (bf16*)(ws + WS_WML + (size_t)mi * 2 * MiB), 0, scr, r, lane); }
                else if (it < 10752) transpose_item(ap->in[11] + (size_t)l * 1024 * FF, FF, FF, 1024, (bf16*)(ws + WS_WUP), 0, scr, it - 8704, lane);
                else transpose_item(ap->in[12] + (size_t)l * FF * 1024, 1024, 1024, FF, (bf16*)(ws + WS_WDN), 0, scr, it - 10752, lane);
            }
            LAS float* Wg = (LAS float*)(L + 73728);
            for (int i = tid; i < 8192; i += 512) Wg[i] = win[(size_t)(i >> 3) * NIN + 4096 + (i & 7)];
            __syncthreads();
            const float* xsrc = l == 0 ? ap->in[0] : out;
            for (int m = gw; m < M; m += NGW)
                norm_row<1>(xsrc + (size_t)m * DM, ap->in[1] + l * DM, XN + (size_t)m * DM, nullptr, Wg, ap->in[3] + l * 8, GATES + (size_t)m * 8, lane);
            __syncthreads();
        } break;
        case 1: case 5: case 10: {
            if (!((PHMASK >> k) & 1)) break; PH_INIT
            const bf16* Bt = k == 1 ? (const bf16*)(ws + WS_WIN) : (k == 5 ? (const bf16*)(ws + WS_WIN) + (size_t)4096 * 1024 : (const bf16*)(ws + WS_WUP));
            const int N = k == 1 ? 4096 : (k == 5 ? 9216 : FF);
            pg8::Gemm g{XN, Bt, M, N, 1024}; pg8::StaticOrder S; S.init(M, N, G, bx);
            pg8::EpiStore E{k == 10 ? (bf16*)(ws + WS_HB) : PA, k == 10 ? FF : 1024, k == 10 ? 0 : 1024, TS, k == 1 ? 0 : (k == 5 ? 1 : 2), 6, k == 5 ? 5 : -1};
            pg8::gemm_phase<pg8::EpiStore, pg8::StaticOrder, true, true>((PG8_LAS unsigned char*)L, g, S, E);
        } break;
        case 8: {
            if (!((PHMASK >> k) & 1)) break; PH_INIT
            pg8::Gemm g{(const bf16*)(ws + WS_MGB), (const bf16*)(ws + WS_WOUT), M, 1024, 1024}; pg8::StaticOrder S; S.init(M, 1024, G, bx);
            pg8::EpiRes E{l == 0 ? ap->in[0] : out, out};
            pg8::gemm_phase<pg8::EpiRes, pg8::StaticOrder, true, true>((PG8_LAS unsigned char*)L, g, S, E);
        } break;
        case 11: {
            if (!((PHMASK >> k) & 1)) break; PH_INIT
            pg8::Gemm g{(const bf16*)(ws + WS_HB), (const bf16*)(ws + WS_WDN), M, 1024, FF}; pg8::StaticOrder S; S.init(M, 1024, G, bx);
            pg8::EpiRes E{out, out};
            pg8::gemm_phase<pg8::EpiRes, pg8::StaticOrder, true, true>((PG8_LAS unsigned char*)L, g, S, E);
        } break;
        case 2: { if (!((PHMASK >> 2) & 1)) break; PH_INIT
            LAS bf16* KT = (LAS bf16*)L; LAS bf16* VT = (LAS bf16*)(L + 36864); LAS float* wS = (LAS float*)(L + 73728);
            for (int u = vcu; u < 1024; u += G) {
                const int bh = u >> 7, c = u & 127, b = bh >> 2, h = bh & 3; const size_t r0 = (size_t)b * SEQ + c * 64;
                v4u kq[2][2], vq[2][2];
#pragma unroll
                for (int i = 0; i < 2; ++i) { const int it = tid + 512 * i, d8 = it >> 5, sp = it & 31; const size_t go = (r0 + 2 * sp) * 1024 + h * 256 + d8 * 8;
                    kq[i][0] = *(const v4u*)(PA + TS + go); kq[i][1] = *(const v4u*)(PA + TS + go + 1024); vq[i][0] = *(const v4u*)(PA + 2 * TS + go); vq[i][1] = *(const v4u*)(PA + 2 * TS + go + 1024); }
                {
                    const float ip = GATES[(r0 + lane) * 8 + h], fp = GATES[(r0 + lane) * 8 + 4 + h];
                    const float bc = wave_prefix(log_sigmoid(fp), lane); const float blast = __shfl(bc, 63);
                    const float gg = blast - bc + ip; const float mloc = wave_max(gg);
                    wS[lane] = __expf(gg - mloc);
                    if (wave == 0 && lane == 0) { MLOC[u] = mloc; BLAST[u] = blast; }
                }
                __syncthreads();
#pragma unroll
                for (int i = 0; i < 2; ++i) { const int it = tid + 512 * i, d8 = it >> 5, sp = it & 31; const float w0 = wS[2 * sp], w1 = wS[2 * sp + 1];
                    LAS unsigned* kt = (LAS unsigned*)(KT + (d8 * 8) * 72 + 2 * sp); LAS unsigned* vt = (LAS unsigned*)(VT + (d8 * 8) * 72 + 2 * sp);
#define KV4(F, J) kt[(J) * 36] = pk2(bflo(kq[i][0].F) * 0.0625f, bflo(kq[i][1].F) * 0.0625f); kt[(J + 1) * 36] = pk2(bfhi(kq[i][0].F) * 0.0625f, bfhi(kq[i][1].F) * 0.0625f); \
                    vt[(J) * 36] = pk2(bflo(vq[i][0].F) * w0, bflo(vq[i][1].F) * w1); vt[(J + 1) * 36] = pk2(bfhi(vq[i][0].F) * w0, bfhi(vq[i][1].F) * w1);
                    KV4(x, 0) KV4(y, 2) KV4(z, 4) KV4(w, 6)
#undef KV4
                }
                __syncthreads();
                if (tid < 256) { float a = 0.f;
#pragma unroll 8
                    for (int s = 0; s < 64; ++s) a += wS[s] * bf2f(KT[tid * 72 + s]);
                    DN[(size_t)u * 256 + tid] = a; }
                bf16* Cg = ST + (size_t)u * 65536;
                {
                    const int krow = wave * 32 + 8 * (lr >> 2) + (lr & 3);
                    const bf16x8 a00 = *(const LAS bf16x8*)(KT + krow * 72 + 8 * lg), a01 = *(const LAS bf16x8*)(KT + krow * 72 + 32 + 8 * lg);
                    const bf16x8 a10 = *(const LAS bf16x8*)(KT + (krow + 4) * 72 + 8 * lg), a11 = *(const LAS bf16x8*)(KT + (krow + 4) * 72 + 32 + 8 * lg);
#pragma unroll 4
                    for (int nb = 0; nb < 16; ++nb) {
                        const bf16x8 b0 = *(const LAS bf16x8*)(VT + (nb * 16 + lr) * 72 + 8 * lg), b1 = *(const LAS bf16x8*)(VT + (nb * 16 + lr) * 72 + 32 + 8 * lg);
                        f32x4 c0 = {0.f, 0.f, 0.f, 0.f}, c1 = {0.f, 0.f, 0.f, 0.f};
                        c0 = __builtin_amdgcn_mfma_f32_16x16x32_bf16(a00, b0, c0, 0, 0, 0); c1 = __builtin_amdgcn_mfma_f32_16x16x32_bf16(a10, b0, c1, 0, 0, 0);
                        c0 = __builtin_amdgcn_mfma_f32_16x16x32_bf16(a01, b1, c0, 0, 0, 0); c1 = __builtin_amdgcn_mfma_f32_16x16x32_bf16(a11, b1, c1, 0, 0, 0);
                        v4u o; o.x = pk2(c0[0], c0[1]); o.y = pk2(c0[2], c0[3]); o.z = pk2(c1[0], c1[1]); o.w = pk2(c1[2], c1[3]);
                        *(v4u*)(Cg + (size_t)(nb * 16 + lr) * 256 + wave * 32 + 8 * lg) = o; }
                }
                __syncthreads();
            }
        } break;
        case 3: { if (!((PHMASK >> 3) & 1)) break; PH_INIT
            LAS float* sA = (LAS float*)L; LAS float* sB = sA + 128; LAS float* sML = sA + 256; LAS float* sBL = sA + 384; LAS float* sM = sA + 512;
            for (int q0 = vcu * 512; q0 < 131072; q0 += G * 512) {
                const int chain = q0 >> 14, eb = q0 & 16383, e4 = eb + tid;
                if (tid < 128) { sML[tid] = MLOC[chain * 128 + tid]; sBL[tid] = BLAST[chain * 128 + tid]; }
                __syncthreads();
                if (tid == 0) { float m = 0.f;
                    for (int c = 0; c < 128; ++c) { sM[c] = m; m = fmaxf(sBL[c] + m, sML[c]); } sM[128] = m; }
                __syncthreads();
                if (tid < 128) { const float m0 = sM[tid], m1 = sM[tid + 1]; sA[tid] = __expf(sBL[tid] + m0 - m1); sB[tid] = __expf(sML[tid] - m1); if (eb == 0 && !dry) MST[chain * 128 + tid] = m0; }
                __syncthreads();
                {
                    unsigned long long* pp = (unsigned long long*)ST + (size_t)chain * 128 * 16384 + e4;
                    float C0 = 0.f, C1 = 0.f, C2 = 0.f, C3 = 0.f;
                    unsigned long long cur[16], nxt[16];
#pragma unroll
                    for (int j = 0; j < 16; ++j) cur[j] = pp[(size_t)j * 16384];
                    for (int c = 0; c < 128; c += 16) {
#pragma unroll
                        for (int j = 0; j < 16; ++j) { const int cn = (c + 16 + j < 128) ? c + 16 + j : 127; nxt[j] = pp[(size_t)cn * 16384]; }
#pragma unroll
                        for (int j = 0; j < 16; ++j) { const float a = sA[c + j], bs = sB[c + j];
                            const unsigned lo = pk2(C0, C1), hi = pk2(C2, C3);
                            if (!dry) pp[(size_t)(c + j) * 16384] = (unsigned long long)lo | ((unsigned long long)hi << 32);
                            const unsigned dlo = (unsigned)cur[j], dhi = (unsigned)(cur[j] >> 32);
                            C0 = a * C0 + bs * bflo(dlo); C1 = a * C1 + bs * bfhi(dlo); C2 = a * C2 + bs * bflo(dhi); C3 = a * C3 + bs * bfhi(dhi); }
#pragma unroll
                        for (int j = 0; j < 16; ++j) cur[j] = nxt[j];
                    }
                }
                if (tid < 8) {
                    float* pn = DN + (size_t)chain * 128 * 256 + (eb >> 9) * 8 + tid; float n = 0.f;
                    for (int c = 0; c < 128; c += 16) { float d[16];
#pragma unroll
                        for (int j = 0; j < 16; ++j) d[j] = pn[(size_t)(c + j) * 256];
#pragma unroll
                        for (int j = 0; j < 16; ++j) { if (!dry) pn[(size_t)(c + j) * 256] = n; n = sA[c + j] * n + sB[c + j] * d[j]; } }
                }
                __syncthreads();
            }
        } break;
        case 4: { if (!((PHMASK >> 4) & 1)) break; PH_INIT
            LAS bf16* Qs = (LAS bf16*)L; LAS bf16* Ks = (LAS bf16*)(L + 33792); LAS float* Sf = (LAS float*)(L + 67584); LAS bf16* VT = (LAS bf16*)(L + 84224);
            LAS bf16* Wt = (LAS bf16*)(L + 43008 + wave * 5120);
            LAS bf16* Pb = Ks;
            LAS float* bcs = (LAS float*)(L + 121088); LAS float* ii = bcs + 64; LAS float* AI = bcs + 128; LAS float* DEN = bcs + 192; LAS float* SSQ = bcs + 256; LAS float* DNs = bcs + 768;
            for (int u = vcu; u < 1024; u += G) {
                int tq_ = tid; asm volatile("" : "+v"(tq_)); const int ltid = tq_, llane = ltid & 63, llr = llane & 15, llg = llane >> 4;
                const int bh = u >> 7, c = u & 127, b = bh >> 2, h = bh & 3; const size_t r0 = (size_t)b * SEQ + c * 64;
                const bf16* Cg = ST + (size_t)u * 65536;
                const float mc = MST[u];
                if (ltid < 256) DNs[ltid] = DN[(size_t)u * 256 + ltid];
                {
                    const float ip = GATES[(r0 + llane) * 8 + h], fp = GATES[(r0 + llane) * 8 + 4 + h];
                    bcs[llane] = wave_prefix(log_sigmoid(fp), llane); ii[llane] = ip;
                }
                for (int it = ltid; it < 2048; it += 512) { const int s = it >> 5, d8 = it & 31; const size_t go = (r0 + s) * 1024 + h * 256 + d8 * 8;
                    const v4u qv = *(const v4u*)(PA + go), kv = *(const v4u*)(PA + TS + go);
                    *(LAS v4u*)(Qs + s * 264 + d8 * 8) = qv;
                    v4u ks; ks.x = pk2(bflo(kv.x) * 0.0625f, bfhi(kv.x) * 0.0625f); ks.y = pk2(bflo(kv.y) * 0.0625f, bfhi(kv.y) * 0.0625f); ks.z = pk2(bflo(kv.z) * 0.0625f, bfhi(kv.z) * 0.0625f); ks.w = pk2(bflo(kv.w) * 0.0625f, bfhi(kv.w) * 0.0625f);
                    *(LAS v4u*)(Ks + s * 264 + d8 * 8) = ks; }
#pragma unroll
                for (int i = 0; i < 2; ++i) { const int it = ltid + 512 * i, d8 = it >> 5, sp = it & 31; const size_t go = (r0 + 2 * sp) * 1024 + h * 256 + d8 * 8;
                    const v4u v0 = *(const v4u*)(PA + 2 * TS + go), v1 = *(const v4u*)(PA + 2 * TS + go + 1024);
                    LAS unsigned* vt = (LAS unsigned*)(VT + (d8 * 8) * 72 + 2 * sp);
#define VP4(F, J) vt[(J) * 36] = (v0.F & 0xffffu) | (v1.F << 16); vt[(J + 1) * 36] = (v0.F >> 16) | (v1.F & 0xffff0000u);
                    VP4(x, 0) VP4(y, 2) VP4(z, 4) VP4(w, 6)
#undef VP4
                }
                bf16x8 cfr[8][2];
#pragma unroll
                for (int kk = 0; kk < 8; ++kk)
#pragma unroll
                    for (int nbi = 0; nbi < 2; ++nbi) cfr[kk][nbi] = *(const bf16x8*)(Cg + (size_t)((wave * 2 + nbi) * 16 + llr) * 256 + (kk >> 1) * 64 + 16 * llg + 8 * (kk & 1));
                __syncthreads();
                {
                    const int tb = wave >> 1;
#pragma unroll
                    for (int sbi = 0; sbi < 2; ++sbi) { const int sb = (wave & 1) * 2 + sbi; f32x4 acc = {0.f, 0.f, 0.f, 0.f};
#pragma unroll
                        for (int kk = 0; kk < 8; ++kk) { const bf16x8 a = *(const LAS bf16x8*)(Qs + (tb * 16 + llr) * 264 + kk * 32 + 8 * llg), bb = *(const LAS bf16x8*)(Ks + (sb * 16 + llr) * 264 + kk * 32 + 8 * llg);
                            acc = __builtin_amdgcn_mfma_f32_16x16x32_bf16(a, bb, acc, 0, 0, 0); }
#pragma unroll
                        for (int r = 0; r < 4; ++r) Sf[(tb * 16 + 4 * llg + r) * 65 + sb * 16 + llr] = acc[r]; }
                }
                __syncthreads();
                {
                    const int t = ltid >> 3, part = ltid & 7; const float bt = bcs[t];
                    float d[8]; float mx = -INFINITY;
#pragma unroll
                    for (int j = 0; j < 8; ++j) { const int s = part * 8 + j; d[j] = (s <= t) ? (bt - bcs[s] + ii[s]) : -INFINITY; mx = fmaxf(mx, d[j]); }
                    mx = fmaxf(mx, __shfl_xor(mx, 1)); mx = fmaxf(mx, __shfl_xor(mx, 2)); mx = fmaxf(mx, __shfl_xor(mx, 4));
                    const float inter = bt + mc, mt = fmaxf(inter, mx);
                    float rs = 0.f; unsigned pw[4];
#pragma unroll
                    for (int j = 0; j < 8; j += 2) { const int s = part * 8 + j;
                        const float p0 = (s <= t) ? Sf[t * 65 + s] * __expf(d[j] - mt) : 0.f, p1 = (s + 1 <= t) ? Sf[t * 65 + s + 1] * __expf(d[j + 1] - mt) : 0.f;
                        rs += p0 + p1; pw[j >> 1] = pk2(p0, p1); }
                    v4u pv; pv.x = pw[0]; pv.y = pw[1]; pv.z = pw[2]; pv.w = pw[3];
                    rs += __shfl_xor(rs, 1); rs += __shfl_xor(rs, 2); rs += __shfl_xor(rs, 4);
                    float dq = 0.f; const LAS float* dn = DNs + part * 32;
#pragma unroll 8
                    for (int kk = 0; kk < 32; ++kk) dq += bf2f(Qs[t * 264 + part * 32 + kk]) * dn[kk];
                    dq += __shfl_xor(dq, 1); dq += __shfl_xor(dq, 2); dq += __shfl_xor(dq, 4);
                    const float ai = __expf(inter - mt);
                    *(LAS v4u*)(Pb + t * 72 + part * 8) = pv;
                    if (part == 0) { AI[t] = ai; DEN[t] = fmaxf(fabsf(rs + ai * dq), __expf(-mt)); }
                }
                __syncthreads();
                {
                    {
                        const bf16* Og = PA + 3 * TS;
#pragma unroll
                        for (int i = 0; i < 4; ++i) { const int row = i * 16 + (llane >> 2), ch = llane & 3;
                            const v4u w = *(const v4u*)(Og + (r0 + row) * 1024 + h * 256 + wave * 32 + ch * 8); *(LAS v4u*)(Wt + row * 40 + ch * 8) = w; }
                    }
                    f32x4 acc[4][2];
#pragma unroll
                    for (int tb = 0; tb < 4; ++tb) { acc[tb][0] = (f32x4){0.f, 0.f, 0.f, 0.f}; acc[tb][1] = (f32x4){0.f, 0.f, 0.f, 0.f}; }
#pragma unroll
                    for (int kk = 0; kk < 8; ++kk) {
                        bf16x8 bfr[2]; bfr[0] = cfr[kk][0]; bfr[1] = cfr[kk][1];
#pragma unroll
                        for (int tb = 0; tb < 4; ++tb) { const bf16x8 a = *(const LAS bf16x8*)(Qs + (tb * 16 + llr) * 264 + (kk >> 1) * 64 + 16 * llg + 8 * (kk & 1));
                            acc[tb][0] = __builtin_amdgcn_mfma_f32_16x16x32_bf16(a, bfr[0], acc[tb][0], 0, 0, 0);
                            acc[tb][1] = __builtin_amdgcn_mfma_f32_16x16x32_bf16(a, bfr[1], acc[tb][1], 0, 0, 0); }
                    }
#pragma unroll
                    for (int tb = 0; tb < 4; ++tb)
#pragma unroll
                        for (int r = 0; r < 4; ++r) { const float ai = AI[tb * 16 + 4 * llg + r]; acc[tb][0][r] *= ai; acc[tb][1][r] *= ai; }
#pragma unroll
                    for (int kk = 0; kk < 2; ++kk) {
                        bf16x8 bfr[2];
#pragma unroll
                        for (int nbi = 0; nbi < 2; ++nbi) bfr[nbi] = *(const LAS bf16x8*)(VT + ((wave * 2 + nbi) * 16 + llr) * 72 + kk * 32 + 8 * llg);
#pragma unroll
                        for (int tb = 0; tb < 4; ++tb) { const bf16x8 a = *(const LAS bf16x8*)(Pb + (tb * 16 + llr) * 72 + kk * 32 + 8 * llg);
                            acc[tb][0] = __builtin_amdgcn_mfma_f32_16x16x32_bf16(a, bfr[0], acc[tb][0], 0, 0, 0);
                            acc[tb][1] = __builtin_amdgcn_mfma_f32_16x16x32_bf16(a, bfr[1], acc[tb][1], 0, 0, 0); }
                    }
                    asm volatile("s_waitcnt lgkmcnt(0)" ::: "memory");
#pragma unroll
                    for (int tb = 0; tb < 4; ++tb)
#pragma unroll
                        for (int r = 0; r < 4; ++r) { const int t = tb * 16 + 4 * llg + r; const float inv = __builtin_amdgcn_rcpf(DEN[t]); float sq = 0.f;
#pragma unroll
                            for (int nbi = 0; nbi < 2; ++nbi) { const float og = bf2f(Wt[t * 40 + nbi * 16 + llr]);
                                const float y = acc[tb][nbi][r] * inv * __builtin_amdgcn_rcpf(1.0f + __expf(-og)); acc[tb][nbi][r] = y; sq += y * y; }
                            sq += __shfl_xor(sq, 1); sq += __shfl_xor(sq, 2); sq += __shfl_xor(sq, 4); sq += __shfl_xor(sq, 8);
                            if (llr == 0) SSQ[wave * 64 + t] = sq; }
                    __syncthreads();
                    const float* gn = ap->in[4] + l * 1024 + h * 256;
                    const float g0 = gn[wave * 32 + llr], g1 = gn[wave * 32 + 16 + llr];
#pragma unroll
                    for (int tb = 0; tb < 4; ++tb)
#pragma unroll
                        for (int r = 0; r < 4; ++r) { const int t = tb * 16 + 4 * llg + r; float tot = 0.f;
#pragma unroll
                            for (int w = 0; w < 8; ++w) tot += SSQ[w * 64 + t];
                            const float rstd = __builtin_amdgcn_rsqf(tot * (1.0f / 256.0f) + EPS);
                            Wt[t * 40 + llr] = f2bf(acc[tb][0][r] * rstd * g0); Wt[t * 40 + 16 + llr] = f2bf(acc[tb][1][r] * rstd * g1); }
                    asm volatile("s_waitcnt lgkmcnt(0)" ::: "memory");
#pragma unroll
                    for (int i = 0; i < 4; ++i) { const int row = i * 16 + (llane >> 2), ch = llane & 3;
                        *(v4u*)(YML + (r0 + row) * 1024 + h * 256 + wave * 32 + ch * 8) = *(const LAS v4u*)(Wt + row * 40 + ch * 8); }
                }
                __syncthreads();
            }
        } break;
        case 6: { if (!((PHMASK >> 6) & 1)) break; PH_INIT
            {
                if (tid == 0) *(LAS unsigned*)L = 0u;
                __syncthreads();
                const bf16* SCB = P2 + TS; const bf16* SCC = P2 + 2 * TS; const bf16* SCU = P2 + 3 * TS; bf16* YSC = (bf16*)(ws + WS_YSC);
                const float* cw = ap->in[5] + (size_t)l * 3 * 1024;
                if (wave < 4) for (int it = vcu * 256 + tid; it < M * 128; it += G * 256) { const int row = it >> 7, c8 = it & 127, t = row & (SEQ - 1); const size_t o = (size_t)row * 1024 + c8 * 8;
                    const v4u bv = *(const v4u*)(SCB + o), c0 = *(const v4u*)(SCC + o), u0 = *(const v4u*)(SCU + o);
                    v4u c1 = {0u, 0u, 0u, 0u}, u1 = c1, c2 = c1, u2 = c1;
                    if (t >= 1) { c1 = *(const v4u*)(SCC + o - 1024); u1 = *(const v4u*)(SCU + o - 1024); }
                    if (t >= 2) { c2 = *(const v4u*)(SCC + o - 2048); u2 = *(const v4u*)(SCU + o - 2048); }
                    const f32x4 w0a = *(const f32x4*)(cw + c8 * 8), w0b = *(const f32x4*)(cw + c8 * 8 + 4), w1a = *(const f32x4*)(cw + 1024 + c8 * 8), w1b = *(const f32x4*)(cw + 1024 + c8 * 8 + 4),
                                w2a = *(const f32x4*)(cw + 2048 + c8 * 8), w2b = *(const f32x4*)(cw + 2048 + c8 * 8 + 4);
                    v4u ov;
#define CONV2(F, WA, E0, E1) pk2(bflo(bv.F) * (WA##0[E0] * bflo(c2.F) * bflo(u2.F) + WA##1[E0] * bflo(c1.F) * bflo(u1.F) + WA##2[E0] * bflo(c0.F) * bflo(u0.F)), \
                                 bfhi(bv.F) * (WA##0[E1] * bfhi(c2.F) * bfhi(u2.F) + WA##1[E1] * bfhi(c1.F) * bfhi(u1.F) + WA##2[E1] * bfhi(c0.F) * bfhi(u0.F)))
                    const f32x4 wa0 = w0a, wa1 = w1a, wa2 = w2a, wb0 = w0b, wb1 = w1b, wb2 = w2b;
                    ov.x = CONV2(x, wa, 0, 1); ov.y = CONV2(y, wa, 2, 3); ov.z = CONV2(z, wb, 0, 1); ov.w = CONV2(w, wb, 2, 3);
#undef CONV2
                    *(v4u*)(YSC + o) = ov; }
            }
            {
                bf16* SBQ = P2; const bf16* SBK = P2 + 4 * TS; const bf16* VTg = P2 + 5 * TS;
                const int nU = (8192 - vcu + G - 1) / G;
                for (;;) { int j = 0; if (lane == 0) j = (int)__hip_atomic_fetch_add((LAS unsigned*)L, 1u, __ATOMIC_RELAXED, __HIP_MEMORY_SCOPE_WORKGROUP);
                    j = __builtin_amdgcn_readfirstlane(j); if (j >= nU) break; const int wu = vcu + G * j;
                    __builtin_amdgcn_s_setprio(2);
                    const int bh = wu >> 8, qt = wu & 255, b = bh >> 4, h = bh & 15, q0 = qt * 32;
                    bf16x8 qf[2][2];
#pragma unroll
                    for (int qb = 0; qb < 2; ++qb)
#pragma unroll
                        for (int kk = 0; kk < 2; ++kk) qf[qb][kk] = *(const bf16x8*)(SBQ + ((size_t)b * SEQ + q0 + qb * 16 + lr) * 1024 + h * 64 + kk * 32 + 8 * lg);
                    f32x4 o[2][4];
#pragma unroll
                    for (int qb = 0; qb < 2; ++qb)
#pragma unroll
                        for (int db = 0; db < 4; ++db) o[qb][db] = (f32x4){0.f, 0.f, 0.f, 0.f};
                    float R[2] = {0.f, 0.f};
                    const bf16* Kb = SBK + (size_t)b * SEQ * 1024 + h * 64 + 8 * lg;
                    const bf16* Vb = VTg + (size_t)(b * 1024 + h * 64 + lr) * SEQ + 4 * lg;
                    bf16x8 kfr[4][2];
                    { const int kt0 = (q0 >> 6) << 6;
#pragma unroll
                      for (int kb = 0; kb < 4; ++kb) { const bf16* kp = Kb + (size_t)(kt0 + kb * 16 + lr) * 1024; kfr[kb][0] = *(const bf16x8*)kp; kfr[kb][1] = *(const bf16x8*)(kp + 32); } }
                    for (int kt = (q0 >> 6) << 6; kt >= 0; kt -= 64) {
                        v2u vlo[2][4], vhi[2][4];
#pragma unroll
                        for (int kk2 = 0; kk2 < 2; ++kk2)
#pragma unroll
                            for (int db = 0; db < 4; ++db) { const bf16* vp = Vb + (size_t)(db * 16) * SEQ + kt + kk2 * 32; vlo[kk2][db] = *(const v2u*)vp; vhi[kk2][db] = *(const v2u*)(vp + 16); }
                        bf16x8 knx[4][2];
                        { const int ktn = kt >= 64 ? kt - 64 : 0;
#pragma unroll
                          for (int kb = 0; kb < 4; ++kb) { const bf16* kp = Kb + (size_t)(ktn + kb * 16 + lr) * 1024; knx[kb][0] = *(const bf16x8*)kp; knx[kb][1] = *(const bf16x8*)(kp + 32); } }
                        f32x4 st[4][2];
#pragma unroll
                        for (int kb = 0; kb < 4; ++kb) {
#pragma unroll
                            for (int qb = 0; qb < 2; ++qb) { f32x4 z4 = {0.f, 0.f, 0.f, 0.f};
                                z4 = __builtin_amdgcn_mfma_f32_16x16x32_bf16(kfr[kb][0], qf[qb][0], z4, 0, 0, 0);
                                st[kb][qb] = __builtin_amdgcn_mfma_f32_16x16x32_bf16(kfr[kb][1], qf[qb][1], z4, 0, 0, 0); } }
                        unsigned pp[2][4][2];
#pragma unroll
                        for (int qb = 0; qb < 2; ++qb) { const int tq = q0 + qb * 16 + lr;
                            float lpv[4][4], lbv[4][4], Hs[4], tot[4];
#pragma unroll
                            for (int kb = 0; kb < 4; ++kb) { float gs = 0.f;
                                if (kt + kb * 16 >= q0 + qb * 16 + 16) {
#pragma unroll
                                    for (int r = 0; r < 4; ++r) { lpv[kb][r] = 0.f; lbv[kb][r] = -INFINITY; }
                                } else {
#pragma unroll
                                for (int r = 0; r < 4; ++r) { const int key = kt + kb * 16 + 4 * lg + r; const float z = st[kb][qb][r] * (0.125f * 1.4426950408889634f);
                                    const float sp = fmaxf(z, 0.f) + __builtin_amdgcn_logf(1.0f + __builtin_amdgcn_exp2f(-fabsf(z)));
                                    const bool act = key < tq; lpv[kb][r] = act ? -sp : 0.f; lbv[kb][r] = act ? z - sp : -INFINITY; gs += lpv[kb][r]; }
                                }
                                const float ga = __shfl_xor(gs, 16), gb = __shfl_xor(gs, 32), gc = __shfl_xor(gs, 48);
                                tot[kb] = (gs + ga) + (gb + gc);
                                Hs[kb] = (((lg ^ 1) > lg) ? ga : 0.f) + (((lg ^ 2) > lg) ? gb : 0.f) + (((lg ^ 3) > lg) ? gc : 0.f); }
                            float base = R[qb];
#pragma unroll
                            for (int kb = 3; kb >= 0; --kb) { float acc = base + Hs[kb]; float pa[4];
#pragma unroll
                                for (int r = 3; r >= 0; --r) { pa[r] = __builtin_amdgcn_exp2f(lbv[kb][r] + acc); acc += lpv[kb][r]; }
                                pp[qb][kb][0] = pk2(pa[0], pa[1]); pp[qb][kb][1] = pk2(pa[2], pa[3]); base += tot[kb]; }
                            R[qb] = base; }
#pragma unroll
                        for (int kk2 = 0; kk2 < 2; ++kk2) {
                            bf16x8 af[2];
#pragma unroll
                            for (int qb = 0; qb < 2; ++qb) { v4u t4; t4.x = pp[qb][2 * kk2][0]; t4.y = pp[qb][2 * kk2][1]; t4.z = pp[qb][2 * kk2 + 1][0]; t4.w = pp[qb][2 * kk2 + 1][1]; af[qb] = __builtin_bit_cast(bf16x8, t4); }
#pragma unroll
                            for (int db = 0; db < 4; ++db) { const v2u lo = vlo[kk2][db], hi = vhi[kk2][db];
                                v4u t4; t4.x = lo.x; t4.y = lo.y; t4.z = hi.x; t4.w = hi.y; const bf16x8 vb = __builtin_bit_cast(bf16x8, t4);
#pragma unroll
                                for (int qb = 0; qb < 2; ++qb) o[qb][db] = __builtin_amdgcn_mfma_f32_16x16x32_bf16(af[qb], vb, o[qb][db], 0, 0, 0); } }
                        if (__all(R[0] < SB_THR * 1.4426950408889634f && R[1] < SB_THR * 1.4426950408889634f)) break;
#pragma unroll
                        for (int kb = 0; kb < 4; ++kb) { kfr[kb][0] = knx[kb][0]; kfr[kb][1] = knx[kb][1]; }
                    }
                    __builtin_amdgcn_s_setprio(0);
                    if (!dry) {
#pragma unroll
                        for (int qb = 0; qb < 2; ++qb)
#pragma unroll
                            for (int db = 0; db < 4; ++db)
#pragma unroll
                                for (int r = 0; r < 4; ++r) SBQ[((size_t)b * SEQ + q0 + qb * 16 + 4 * lg + r) * 1024 + h * 64 + db * 16 + lr] = f2bf(o[qb][db][r]);
                    }
                }
            }
        } break;
        case 7: { if (!((PHMASK >> 7) & 1)) break; PH_INIT
            pg8::Gemm g{(const bf16*)(ws + WS_XN), (const bf16*)(ws + WS_WML), 3 * M, 3072, 1024}; pg8::GateSched S; S.base.init(M, 1024, G, bx);
            pg8::EpiGate E{P2 + (size_t)6 * TS, (float*)(ws + WS_MG), (bf16*)(ws + WS_MGB), TS};
            pg8::gemm_phase<pg8::EpiGate, pg8::GateSched, true, true>((PG8_LAS unsigned char*)L, g, S, E);
        } break;
        case 9: { if (!((PHMASK >> 9) & 1)) break; PH_INIT
            const int gw = vcu * 8 + wave, NGW = G * 8;
            for (int m = gw; m < M; m += 2 * NGW) { const int m1 = m + NGW;
                if (m1 < M) norm_row_pair<0>(out + (size_t)m * DM, out + (size_t)m1 * DM, ap->in[10] + l * DM, XN + (size_t)m * DM, XN + (size_t)m1 * DM, nullptr, nullptr, lane);
                else norm_row<0>(out + (size_t)m * DM, ap->in[10] + l * DM, XN + (size_t)m * DM, nullptr, nullptr, nullptr, nullptr, lane); }
        } break;
        default: { if (!((PHMASK >> 12) & 1)) break; PH_INIT
            const int gw = vcu * 8 + wave, NGW = G * 8;
            for (int m = gw; m < M; m += 2 * NGW) { const int m1 = m + NGW;
                if (m1 < M) norm_row_pair<2>(out + (size_t)m * DM, out + (size_t)m1 * DM, ap->in[13], nullptr, nullptr, out + (size_t)m * DM, out + (size_t)m1 * DM, lane);
                else norm_row<2>(out + (size_t)m * DM, ap->in[13], nullptr, out + (size_t)m * DM, nullptr, nullptr, nullptr, lane); }
        } break;
        }
        }
    }
}

#ifndef MK_PER_PHASE
#define MK_PER_PHASE 0
#endif
extern "C" void kernel_launch(void* const* d_in, const int* in_sizes, int n_in, void* d_out, int out_size, void* d_ws, size_t ws_size, hipStream_t stream) {
    static int grid = 0;
    if (grid == 0) {
        if (n_in != 14 || out_size != M * DM || ws_size < WS_END) { fprintf(stderr, "kernel_launch: unexpected shapes (n_in %d, out %d, ws %zu)\n", n_in, out_size, ws_size); grid = -1; return; }
        int dev = 0, cus = 0, per_cu = 0;
        hipGetDevice(&dev); hipDeviceGetAttribute(&cus, hipDeviceAttributeMultiprocessorCount, dev);
        if (hipFuncSetAttribute((const void*)mega, hipFuncAttributeMaxDynamicSharedMemorySize, LDS_BYTES) != hipSuccess) { fprintf(stderr, "kernel_launch: hipFuncSetAttribute failed\n"); grid = -1; return; }
        if (hipOccupancyMaxActiveBlocksPerMultiprocessor(&per_cu, (const void*)mega, 512, LDS_BYTES) != hipSuccess || per_cu < 1) { fprintf(stderr, "kernel_launch: occupancy query gave %d\n", per_cu); per_cu = 1; }
        (void)hipGetLastError();
        grid = cus * 1;
        fprintf(stderr, "kernel_launch: cus %d per_cu %d grid %d\n", cus, per_cu, grid);
    }
    if (grid < 0) return;
    if (hipMemsetAsync(d_ws, 0, 16384, stream) != hipSuccess) { fprintf(stderr, "kernel_launch: memset of the barrier words failed\n"); return; }
    Args a{};
    for (int i = 0; i < 14; ++i) a.in[i] = (const float*)d_in[i];
    a.out = (float*)d_out; a.ws = (unsigned char*)d_ws;
#if MK_PER_PHASE
    for (int p = 0; p < 2 * NPH + 1; ++p) { a.ph_lo = p; a.ph_hi = p + 1; hipLaunchKernelGGL(mega, dim3(grid), dim3(512), LDS_BYTES, stream, a); }
#else
    a.ph_lo = 0; a.ph_hi = 2 * NPH + 1;
    void* kargs[] = {&a};
    hipError_t e = hipLaunchCooperativeKernel((const void*)mega, dim3(grid), dim3(512), kargs, LDS_BYTES, stream);
    if (e != hipSuccess) fprintf(stderr, "kernel_launch: cooperative launch failed: %s (grid %d)\n", hipGetErrorString(e), grid);
#endif
}
```
